# Optimizing an MI355X kernel written in HIP

```python
import jax, jax.numpy as jnp
from jax import lax
import numpy as np

D_MODEL = 2048
BATCH = 4
SEQ = 4096
DEPTH = 4

N_EVEN = (DEPTH + 1) // 2
N_ODD = DEPTH // 2
NORM_EPS = 1e-6

CONV_DIM = D_MODEL // 2
CONV_WIDTH = 3
RWKV_DIM = D_MODEL // 2
RWKV_HEAD = 64
RWKV_HEADS = RWKV_DIM // RWKV_HEAD
W_LORA = 64
A_LORA = 64
G_LORA = 160
GN_EPS = 64e-5
RWKV_IN = 3 * RWKV_DIM + W_LORA + A_LORA + G_LORA
EVEN_IN = 3 * CONV_DIM + RWKV_IN
EVEN_OUT = CONV_DIM + RWKV_DIM
POOL_WINDOWS = (2, 4, 8, 16)
POOL_GROUP = D_MODEL // 16
POOL_DIM = len(POOL_WINDOWS) * POOL_GROUP
MLA_HEADS = 12
Q_LORA = 512
KV_LORA = 512
QK_NOPE = 128
QK_ROPE = 64
V_HEAD = 128
ROPE_THETA = 10000.0
ATTN_BLOCK = 128
ODD_IN = POOL_DIM + Q_LORA + KV_LORA + QK_ROPE
ODD_OUT = POOL_DIM + MLA_HEADS * V_HEAD
D_FF = ((8 * D_MODEL + 3 * 256 - 1) // (3 * 256)) * 256

kernel_name = 'hybrid_conv_rwkv7_pool_mla_trunk'


def rms_norm(x, g):
    xf = x.astype(jnp.float32)
    y = xf * lax.rsqrt(jnp.mean(xf * xf, axis=-1, keepdims=True) + NORM_EPS)
    return (y * g.astype(jnp.float32)).astype(x.dtype)


def shift_seq(u, n):
    return jnp.pad(u, ((0, 0), (n, 0), (0, 0)))[:, :u.shape[1]]


def short_conv_mixer(p, conv_w):
    b_gate, c_gate, h = jnp.split(p, 3, axis=-1)
    u = c_gate * h
    y = conv_w[:, 2] * u + conv_w[:, 1] * shift_seq(u, 1) + conv_w[:, 0] * shift_seq(u, 2)
    return b_gate * y


def wkv7_scan(r, decay, k, v, kk, a):
    bsz, _, nh, n = r.shape

    def step(state, inp):
        r_t, w_t, k_t, v_t, kk_t, a_t = inp
        sa = jnp.einsum('bhvk,bhk->bhv', state, -kk_t)
        state = (state * w_t[:, :, None, :]
                 + sa[..., None] * (kk_t * a_t)[:, :, None, :]
                 + v_t[..., None] * k_t[:, :, None, :])
        y_t = jnp.einsum('bhvk,bhk->bhv', state, r_t)
        return state, y_t

    xs = tuple(jnp.moveaxis(t, 1, 0) for t in (r, decay, k, v, kk, a))
    init = jnp.zeros((bsz, nh, n, n), jnp.float32)
    _, ys = lax.scan(step, init, xs)
    return jnp.moveaxis(ys, 0, 1)


def rwkv7_mixer(p, mu, w0, w2, a0, a2, g2, k_k, k_a, r_k, ln_w, ln_b):
    bsz, s = p.shape[:2]
    p = p.astype(jnp.float32)
    p = p + (shift_seq(p, 1) - p) * mu
    r, k, v, xw, xa, xg = jnp.split(
        p, [RWKV_DIM, 2 * RWKV_DIM, 3 * RWKV_DIM, 3 * RWKV_DIM + W_LORA,
            3 * RWKV_DIM + W_LORA + A_LORA], axis=-1)
    w = -jax.nn.softplus(-(w0 + jnp.tanh(xw) @ w2)) - 0.5
    a = jax.nn.sigmoid(a0 + xa @ a2)
    g = jax.nn.sigmoid(xg) @ g2
    hs = lambda t: t.reshape(bsz, s, RWKV_HEADS, RWKV_HEAD)
    kk = hs(k * k_k)
    kk = kk / jnp.maximum(jnp.linalg.norm(kk, axis=-1, keepdims=True), 1e-12)
    k = k * (1.0 + (a - 1.0) * k_a)
    r, k, v, a, w = hs(r), hs(k), hs(v), hs(a), hs(w)
    decay = jnp.exp(-jnp.exp(w))
    y = wkv7_scan(r, decay, k, v, kk, a)
    mean = jnp.mean(y, axis=-1, keepdims=True)
    var = jnp.mean(jnp.square(y - mean), axis=-1, keepdims=True)
    y = ((y - mean) * lax.rsqrt(var + GN_EPS)).reshape(bsz, s, RWKV_DIM) * ln_w + ln_b
    bonus = jnp.sum(r * k * r_k, axis=-1, keepdims=True) * v
    y = y + bonus.reshape(bsz, s, RWKV_DIM)
    return y * g


def pool_mixer(u, pool_w, pool_scale):
    bsz, s = u.shape[:2]
    uf = u.astype(jnp.float32)
    cs = jnp.cumsum(uf, axis=1)
    pos = jnp.arange(s)
    diffs = []
    for gi, win in enumerate(POOL_WINDOWS):
        sl = slice(gi * POOL_GROUP, (gi + 1) * POOL_GROUP)
        c = cs[..., sl]
        count = jnp.minimum(pos + 1, win).astype(jnp.float32)[None, :, None]
        diffs.append((c - shift_seq(c, win)) / count - uf[..., sl])
    d = jnp.stack(diffs, axis=2)
    y = jnp.einsum('bsgi,gio->bsgo', d, pool_w).reshape(bsz, s, POOL_DIM)
    return y * pool_scale


def rope_tables(positions):
    inv = 1.0 / (ROPE_THETA ** (jnp.arange(0, QK_ROPE, 2, dtype=jnp.float32) / QK_ROPE))
    ang = positions.astype(jnp.float32)[..., None] * inv
    return jnp.cos(ang), jnp.sin(ang)


def apply_rope(t, cos, sin):
    t = t.astype(jnp.float32)
    t1, t2 = jnp.split(t, 2, axis=-1)
    c, s = cos[:, :, None, :], sin[:, :, None, :]
    return jnp.concatenate([t1 * c - t2 * s, t1 * s + t2 * c], axis=-1)


def mla_mixer(q_lat, kv_lat, k_pe, q_norm, w_uq, kv_norm, w_ukv, cos, sin):
    bsz, s = q_lat.shape[:2]
    q = (rms_norm(q_lat, q_norm) @ w_uq).reshape(bsz, s, MLA_HEADS, QK_NOPE + QK_ROPE)
    kv = (rms_norm(kv_lat, kv_norm) @ w_ukv).reshape(bsz, s, MLA_HEADS, QK_NOPE + V_HEAD)
    q_nope = q[..., :QK_NOPE].astype(jnp.float32)
    q_pe = apply_rope(q[..., QK_NOPE:], cos, sin)
    k_nope = kv[..., :QK_NOPE].astype(jnp.float32)
    v = kv[..., QK_NOPE:].astype(jnp.float32)
    k_pe = apply_rope(k_pe[:, :, None, :], cos, sin)[:, :, 0]
    scale = (QK_NOPE + QK_ROPE) ** -0.5
    outs = []
    for i in range(s // ATTN_BLOCK):
        s0, e = i * ATTN_BLOCK, (i + 1) * ATTN_BLOCK
        sc = (jnp.einsum('bqhd,bkhd->bhqk', q_nope[:, s0:e], k_nope[:, :e])
              + jnp.einsum('bqhr,bkr->bhqk', q_pe[:, s0:e], k_pe[:, :e])) * scale
        mask = (s0 + jnp.arange(ATTN_BLOCK))[:, None] >= jnp.arange(e)[None, :]
        pr = jax.nn.softmax(jnp.where(mask, sc, -1e30), axis=-1)
        outs.append(jnp.einsum('bhqk,bkhd->bqhd', pr, v[:, :e]))
    o = jnp.concatenate(outs, axis=1)
    return o.reshape(bsz, s, MLA_HEADS * V_HEAD)


def swiglu(x, wg, wu, wd):
    return (jax.nn.silu(x @ wg) * (x @ wu)) @ wd


def setup_inputs(seed: int = 0) -> dict:
    key = jax.random.key(seed)
    ks = iter(jax.random.split(key, 40))
    nrm = lambda shape, fan_in: jax.random.normal(next(ks), shape, jnp.float32) * (fan_in ** -0.5)
    gain = lambda shape: 1.0 + 0.02 * jax.random.normal(next(ks), shape, jnp.float32)
    x = jax.random.normal(next(ks), (BATCH, SEQ, D_MODEL), jnp.float32)
    offs = jax.random.randint(next(ks), (BATCH, 1), 0, 1024, dtype=jnp.int32)
    positions = (offs + jnp.arange(SEQ, dtype=jnp.int32)[None, :]).astype(jnp.int32)
    return {
        'x': x,
        'positions': positions,
        'ev_norm': gain((N_EVEN, D_MODEL)),
        'ev_w_in': nrm((N_EVEN, D_MODEL, EVEN_IN), D_MODEL),
        'ev_conv_w': nrm((N_EVEN, CONV_DIM, CONV_WIDTH), CONV_WIDTH),
        'ev_mu': jax.random.uniform(next(ks), (N_EVEN, RWKV_IN), jnp.float32),
        'ev_w0': jax.random.uniform(next(ks), (N_EVEN, RWKV_DIM), jnp.float32, -6.5, -1.5),
        'ev_w2': nrm((N_EVEN, W_LORA, RWKV_DIM), W_LORA),
        'ev_a0': 0.1 * jax.random.normal(next(ks), (N_EVEN, RWKV_DIM), jnp.float32),
        'ev_a2': nrm((N_EVEN, A_LORA, RWKV_DIM), A_LORA),
        'ev_g2': nrm((N_EVEN, G_LORA, RWKV_DIM), G_LORA),
        'ev_k_k': 0.85 + 0.05 * jax.random.normal(next(ks), (N_EVEN, RWKV_DIM), jnp.float32),
        'ev_k_a': 1.0 + 0.05 * jax.random.normal(next(ks), (N_EVEN, RWKV_DIM), jnp.float32),
        'ev_r_k': 0.1 * jax.random.normal(next(ks), (N_EVEN, RWKV_HEADS, RWKV_HEAD), jnp.float32),
        'ev_ln_w': gain((N_EVEN, RWKV_DIM)),
        'ev_ln_b': 0.02 * jax.random.normal(next(ks), (N_EVEN, RWKV_DIM), jnp.float32),
        'ev_w_out': nrm((N_EVEN, EVEN_OUT, D_MODEL), EVEN_OUT),
        'od_norm': gain((N_ODD, D_MODEL)),
        'od_w_in': nrm((N_ODD, D_MODEL, ODD_IN), D_MODEL),
        'od_pool_w': nrm((N_ODD, len(POOL_WINDOWS), POOL_GROUP, POOL_GROUP), POOL_GROUP),
        'od_pool_scale': 0.5 + 0.1 * jax.random.normal(next(ks), (N_ODD, POOL_DIM), jnp.float32),
        'od_q_norm': gain((N_ODD, Q_LORA)),
        'od_w_uq': nrm((N_ODD, Q_LORA, MLA_HEADS * (QK_NOPE + QK_ROPE)), Q_LORA),
        'od_kv_norm': gain((N_ODD, KV_LORA)),
        'od_w_ukv': nrm((N_ODD, KV_LORA, MLA_HEADS * (QK_NOPE + V_HEAD)), KV_LORA),
        'od_w_out': nrm((N_ODD, ODD_OUT, D_MODEL), ODD_OUT),
        'ffn_norm': gain((DEPTH, D_MODEL)),
        'ffn_w_gate': nrm((DEPTH, D_MODEL, D_FF), D_MODEL),
        'ffn_w_up': nrm((DEPTH, D_MODEL, D_FF), D_MODEL),
        'ffn_w_down': nrm((DEPTH, D_FF, D_MODEL), D_FF),
        'final_norm': gain((D_MODEL,)),
    }


def reference(x, positions, ev_norm, ev_w_in, ev_conv_w, ev_mu, ev_w0, ev_w2, ev_a0, ev_a2,
              ev_g2, ev_k_k, ev_k_a, ev_r_k, ev_ln_w, ev_ln_b, ev_w_out, od_norm, od_w_in,
              od_pool_w, od_pool_scale, od_q_norm, od_w_uq, od_kv_norm, od_w_ukv, od_w_out,
              ffn_norm, ffn_w_gate, ffn_w_up, ffn_w_down, final_norm):
    dt = x.dtype
    cos, sin = rope_tables(positions)
    h = x
    for layer in range(DEPTH):
        j = layer // 2
        if layer % 2 == 0:
            p = rms_norm(h, ev_norm[j]) @ ev_w_in[j]
            ya = short_conv_mixer(p[..., :3 * CONV_DIM], ev_conv_w[j])
            yb = rwkv7_mixer(p[..., 3 * CONV_DIM:], ev_mu[j], ev_w0[j], ev_w2[j], ev_a0[j],
                             ev_a2[j], ev_g2[j], ev_k_k[j], ev_k_a[j], ev_r_k[j],
                             ev_ln_w[j], ev_ln_b[j])
            mix = jnp.concatenate([ya.astype(dt), yb.astype(dt)], axis=-1)
            h = h + mix @ ev_w_out[j]
        else:
            p = rms_norm(h, od_norm[j]) @ od_w_in[j]
            o1 = POOL_DIM
            o2 = o1 + Q_LORA
            o3 = o2 + KV_LORA
            yc = pool_mixer(p[..., :o1], od_pool_w[j], od_pool_scale[j])
            yd = mla_mixer(p[..., o1:o2], p[..., o2:o3], p[..., o3:], od_q_norm[j],
                           od_w_uq[j], od_kv_norm[j], od_w_ukv[j], cos, sin)
            mix = jnp.concatenate([yc.astype(dt), yd.astype(dt)], axis=-1)
            h = h + mix @ od_w_out[j]
        h = h + swiglu(rms_norm(h, ffn_norm[layer]), ffn_w_gate[layer], ffn_w_up[layer],
                       ffn_w_down[layer])
    return rms_norm(h, final_norm)
```

```cpp
#define REPSEL 0
#include <hip/hip_runtime.h>
#include <hip/hip_cooperative_groups.h>
#include <cstdio>
#include <cstdint>
namespace cg = cooperative_groups;
namespace pg8 {
#define PG8_LAS __attribute__((address_space(3)))
typedef unsigned short bf16_t;
typedef short bf16x8 __attribute__((ext_vector_type(8)));
typedef float f32x4 __attribute__((ext_vector_type(4)));
typedef unsigned u32x4 __attribute__((ext_vector_type(4)));
constexpr int BM = 256, BK = 64, HALF = 128, HTB = HALF * BK * 2  , STAGE_BYTES = 8 * HTB, NXCD = 8, WGM = 4;

__host__ __device__ __forceinline__ int lds_byte(int r, int c) { const int st = (r >> 4) * 2 + (c >> 5), rr = r & 15, cc = c & 31, ob = rr * 64 + cc * 2; return st * 1024 + (ob ^ (((ob >> 9) & 1) << 5)); }
__host__ __device__ __forceinline__ void stage_rc(int b, int& R, int& C) { const int st = b / 1024, sb = b % 1024, swz = sb ^ (((sb >> 9) & 1) << 5); R = (st >> 1) * 16 + swz / 64; C = (st & 1) * 32 + (swz % 64) / 2; }
__host__ __device__ __forceinline__ int perm32(int rho) { const int n = rho >> 4, i = rho & 15; return 8 * (i >> 2) + 4 * n + (i & 3); }

struct Unit { int pm, pn; };
struct Gemm { const bf16_t* A; const bf16_t* Bt; int M, N, K; };

struct StaticOrder {
    int nM, nN, nwg, G, c;
    __host__ __device__ void init(int M, int N, int G_, int c_) { nM = M / BM; nN = N / BM; nwg = nM * nN; G = G_; c = c_; }
    __host__ __device__ bool next(int i, Unit& u) const {
        const long L = (long)i * G + c; if (L >= nwg) return false;
        int wgid = (int)L; { const int q = nwg / NXCD, r = nwg % NXCD, xcd = wgid % NXCD, off = wgid / NXCD; wgid = (xcd < r ? xcd * (q + 1) : r * (q + 1) + (xcd - r) * q) + off; }
        const int nig = WGM * nN, gid = wgid / nig, fm = gid * WGM, gsz = (nM - fm) < WGM ? (nM - fm) : WGM;
        u.pm = fm + ((wgid % nig) % gsz); u.pn = (wgid % nig) / gsz; return true;
    }
    __device__ __forceinline__ void a_ready(const Unit&) const {}
    __device__ __forceinline__ void done(const Unit&) const {}
};

__device__ __forceinline__ unsigned cvt_pk_bf16(float lo, float hi) { unsigned r; asm volatile("v_cvt_pk_bf16_f32 %0, %1, %2" : "=v"(r) : "v"(lo), "v"(hi)); return r; }
typedef float f32x2e __attribute__((ext_vector_type(2))); typedef __bf16 bf16x2e __attribute__((ext_vector_type(2)));
__device__ __forceinline__ unsigned pk_bf16(float lo, float hi) { f32x2e v = {lo, hi}; bf16x2e b = __builtin_convertvector(v, bf16x2e); return __builtin_bit_cast(unsigned, b); }
__device__ __forceinline__ float group_rstd(const float* ssp, int rowbase, int fr, int fq) {
    const int lane = fq * 16 + fr;
    const f32x4* p = (const f32x4*)(ssp + (size_t)(rowbase + (lane >> 2)) * 32 + (lane & 3) * 8);
    const f32x4 a = p[0], b = p[1];
    float t = ((a.x + a.y) + (a.z + a.w)) + ((b.x + b.y) + (b.z + b.w));
    t += __shfl_xor(t, 1); t += __shfl_xor(t, 2);
    const float rs = rsqrtf(t * (1.0f / 2048.0f) + 1e-6f);
    return __shfl(rs, fr * 4);
}
__device__ __forceinline__ void tile_rstd(float (&rs)[2][4], const float* ssp, int rowtile, int wr, int fr, int fq) {
    const int lane = fq * 16 + fr; f32x4 pa[2][4][2];
#pragma unroll
    for (int ai = 0; ai < 2; ++ai)
#pragma unroll
        for (int m = 0; m < 4; ++m) { const f32x4* p = (const f32x4*)(ssp + (size_t)(rowtile + wr * 64 + ai * HALF + m * 16 + (lane >> 2)) * 32 + (lane & 3) * 8); pa[ai][m][0] = p[0]; pa[ai][m][1] = p[1]; }
#pragma unroll
    for (int ai = 0; ai < 2; ++ai)
#pragma unroll
        for (int m = 0; m < 4; ++m) { const f32x4 a = pa[ai][m][0], b = pa[ai][m][1];
            float t = ((a.x + a.y) + (a.z + a.w)) + ((b.x + b.y) + (b.z + b.w));
            t += __shfl_xor(t, 1); t += __shfl_xor(t, 2);
            rs[ai][m] = __shfl(rsqrtf(t * (1.0f / 2048.0f) + 1e-6f), fr * 4); }
}
struct EpiStore {
    static constexpr bool PERM = true, AFTER_DRAIN = false;
    bf16_t* O; int ldc; const float* ss;
    __device__ __forceinline__ void operator()(const f32x4 (&acc)[2][2][4][2], const Unit& u, int wr, int wc, int fr, int fq) const {
        const int row0 = u.pm * BM + wr * 64 + fr; const int col0 = u.pn * BM + wc * 32 + 8 * fq;
        float rsa[2][4];
#pragma unroll
        for (int ai = 0; ai < 2; ++ai)
#pragma unroll
            for (int m = 0; m < 4; ++m) rsa[ai][m] = 1.0f;
        if (ss) tile_rstd(rsa, ss, u.pm * BM, wr, fr, fq);
#pragma unroll
        for (int ai = 0; ai < 2; ++ai)
#pragma unroll
            for (int m = 0; m < 4; ++m) { bf16_t* rowp = O + (size_t)(row0 + ai * HALF + m * 16) * ldc + col0;
                const float rs = rsa[ai][m];
#pragma unroll
                for (int bj = 0; bj < 2; ++bj) { const f32x4 v0 = acc[ai][bj][m][0] * rs, v1 = acc[ai][bj][m][1] * rs;
                    u32x4 w; w.x = pk_bf16(v0[0], v0[1]); w.y = pk_bf16(v0[2], v0[3]); w.z = pk_bf16(v1[0], v1[1]); w.w = pk_bf16(v1[2], v1[3]);
                    *(u32x4*)(rowp + bj * HALF) = w; } }
    }
};
__device__ __forceinline__ float silu_mul(float g, float u) { return g * __builtin_amdgcn_rcpf(1.0f + __builtin_amdgcn_exp2f(-1.4426950408889634f * g)) * u; }
struct EpiSwiglu {
    static constexpr bool PERM = true, AFTER_DRAIN = false;
    bf16_t* O; int ldc; const float* ss;
    __device__ __forceinline__ void operator()(const f32x4 (&acc)[2][2][4][2], const Unit& u, int wr, int wc, int fr, int fq) const {
        const int row0 = u.pm * BM + wr * 64 + fr; const int col0 = u.pn * HALF + wc * 32 + 8 * fq;
        float rsa[2][4]; tile_rstd(rsa, ss, u.pm * BM, wr, fr, fq);
#pragma unroll
        for (int ai = 0; ai < 2; ++ai)
#pragma unroll
            for (int m = 0; m < 4; ++m) { bf16_t* rowp = O + (size_t)(row0 + ai * HALF + m * 16) * ldc + col0;
                const float rs = rsa[ai][m];
                const f32x4 g0 = acc[ai][0][m][0] * rs, g1 = acc[ai][0][m][1] * rs, u0 = acc[ai][1][m][0] * rs, u1 = acc[ai][1][m][1] * rs;
                u32x4 w; w.x = pk_bf16(silu_mul(g0[0], u0[0]), silu_mul(g0[1], u0[1])); w.y = pk_bf16(silu_mul(g0[2], u0[2]), silu_mul(g0[3], u0[3]));
                w.z = pk_bf16(silu_mul(g1[0], u1[0]), silu_mul(g1[1], u1[1])); w.w = pk_bf16(silu_mul(g1[2], u1[2]), silu_mul(g1[3], u1[3]));
                *(u32x4*)rowp = w; }
    }
};
struct EpiResid {
    static constexpr bool PERM = true, AFTER_DRAIN = false;
    bf16_t* H; int ldc; float* ss;
    __device__ __forceinline__ void operator()(const f32x4 (&acc)[2][2][4][2], const Unit& u, int wr, int wc, int fr, int fq) const {
        const int col0 = u.pn * BM + wc * 32 + 8 * fq;
        bf16_t* base = H + (size_t)(u.pm * BM + wr * 64 + fr) * ldc + col0;
        u32x4 r[2][4][2];
#pragma unroll
        for (int ai = 0; ai < 2; ++ai)
#pragma unroll
            for (int m = 0; m < 4; ++m)
#pragma unroll
                for (int bj = 0; bj < 2; ++bj) r[ai][m][bj] = *(const u32x4*)(base + (size_t)(ai * HALF + m * 16) * ldc + bj * HALF);
#pragma unroll
        for (int ai = 0; ai < 2; ++ai)
#pragma unroll
            for (int m = 0; m < 4; ++m) { const int row = u.pm * BM + ai * HALF + wr * 64 + m * 16 + fr; bf16_t* rowp = base + (size_t)(ai * HALF + m * 16) * ldc;
                float qs = 0.f;
#pragma unroll
                for (int bj = 0; bj < 2; ++bj) { const f32x4 a0 = acc[ai][bj][m][0], a1 = acc[ai][bj][m][1]; const u32x4 q = r[ai][m][bj]; u32x4 w;
                    w.x = pk_bf16(__uint_as_float(q.x << 16) + a0.x, __uint_as_float(q.x & 0xffff0000u) + a0.y);
                    w.y = pk_bf16(__uint_as_float(q.y << 16) + a0.z, __uint_as_float(q.y & 0xffff0000u) + a0.w);
                    w.z = pk_bf16(__uint_as_float(q.z << 16) + a1.x, __uint_as_float(q.z & 0xffff0000u) + a1.y);
                    w.w = pk_bf16(__uint_as_float(q.w << 16) + a1.z, __uint_as_float(q.w & 0xffff0000u) + a1.w);
                    *(u32x4*)(rowp + bj * HALF) = w;
#pragma unroll
                    for (int e = 0; e < 4; ++e) { const float h0 = __uint_as_float(w[e] << 16), h1 = __uint_as_float(w[e] & 0xffff0000u); qs += h0 * h0 + h1 * h1; } }
                qs += __shfl_xor(qs, 16); qs += __shfl_xor(qs, 32);
                if (fq == 0) ss[(size_t)row * 32 + u.pn * 4 + wc] = qs; }
    }
};
template <class Epi, class Sched, bool ALIGN_EPI = false, bool SP2 = false>
__device__ __forceinline__ void gemm_phase(PG8_LAS unsigned char* lds, const Gemm g, const Sched& S, const Epi& E) {
    int tid_l = threadIdx.x; asm volatile("" : "+v"(tid_l)); const int tid = tid_l, wid = __builtin_amdgcn_readfirstlane(tid >> 6), lane = tid & 63, wr = wid >> 2, wc = wid & 3, fr = lane & 15, fq = lane >> 4;
    const int K = g.K, nt = K / BK;
    unsigned voffA[2], voffB[2];
#pragma unroll
    for (int i = 0; i < 2; ++i) { int R, C; stage_rc(tid * 16 + i * 8192, R, C); const int Rb = Epi::PERM ? ((R & ~31) + perm32(R & 31)) : R;
        voffA[i] = (unsigned)(R * K + C) * 2u; voffB[i] = (unsigned)(Rb * K + C) * 2u; }
    const size_t kstep = (size_t)(BK * 2);
    const size_t hstep = (size_t)HALF * K * 2;
    const size_t tstep = 2 * hstep;
    const unsigned ldsw = (unsigned)wid * 1024u;
    const int aoff = lds_byte(wr * 64 + fr, fq * 8), boff = lds_byte(wc * 32 + fr, fq * 8);
#define PG8_SA(b, h) (((b) * 2 + (h)) * HTB)
#define PG8_SB(b, h) ((4 + (b) * 2 + (h)) * HTB)
#define PG8_STAGE(bufoff, gbase, voff) do { _Pragma("unroll") for (int _i = 0; _i < 2; ++_i) \
        __builtin_amdgcn_global_load_lds((const unsigned*)((const char*)(gbase) + (voff)[_i]), (PG8_LAS unsigned*)(lds + (bufoff) + ldsw + _i * 8192), 16, 0, 0); } while (0)
#define PG8_LDA(dst, b, h) do { _Pragma("unroll") for (int m = 0; m < 4; ++m) _Pragma("unroll") for (int k = 0; k < 2; ++k) dst[m][k] = *(const PG8_LAS bf16x8*)(lds + PG8_SA(b, h) + aoff + m * 2048 + k * 1024); } while (0)
#define PG8_LDB(dst, b, h) do { _Pragma("unroll") for (int n = 0; n < 2; ++n) _Pragma("unroll") for (int k = 0; k < 2; ++k) dst[n][k] = *(const PG8_LAS bf16x8*)(lds + PG8_SB(b, h) + boff + n * 2048 + k * 1024); } while (0)
#define PG8_MMA(ai, bj, At, Bt) do { __builtin_amdgcn_s_setprio(1); _Pragma("unroll") for (int m = 0; m < 4; ++m) _Pragma("unroll") for (int n = 0; n < 2; ++n) _Pragma("unroll") for (int k = 0; k < 2; ++k) \
        acc[ai][bj][m][n] = __builtin_amdgcn_mfma_f32_16x16x32_bf16(Bt[n][k], At[m][k], acc[ai][bj][m][n], 0, 0, 0); __builtin_amdgcn_s_setprio(0); } while (0)
#define PG8_WAIT_V(n) asm volatile("s_waitcnt vmcnt(" #n ")" ::: "memory")
#define PG8_WAIT_L(n) asm volatile("s_waitcnt lgkmcnt(" #n ")" ::: "memory")
#define PG8_BAR __builtin_amdgcn_s_barrier()
#define PG8_SCHED __builtin_amdgcn_sched_barrier(0)
    Unit cur, nxt; int ui = 0;
    if (!S.next(0, cur)) return;
    f32x4 acc[2][2][4][2];
#pragma unroll
    for (int a = 0; a < 2; ++a)
#pragma unroll
        for (int b = 0; b < 2; ++b)
#pragma unroll
            for (int m = 0; m < 4; ++m)
#pragma unroll
                for (int n = 0; n < 2; ++n) acc[a][b][m][n] = (f32x4){0.f, 0.f, 0.f, 0.f};
    bf16x8 At[4][2], B0[2][2], B1[2][2];
    const char* cA = (const char*)g.A + (size_t)cur.pm * tstep; const char* cB = (const char*)g.Bt + (size_t)cur.pn * tstep;
    S.a_ready(cur);
    if constexpr (SP2) {
        PG8_STAGE(PG8_SB(0, 0), cB, voffB); PG8_STAGE(PG8_SB(0, 1), cB + hstep, voffB); PG8_STAGE(PG8_SA(0, 0), cA, voffA); PG8_STAGE(PG8_SA(0, 1), cA + hstep, voffA);
        if (wr == 1) PG8_BAR;
        PG8_WAIT_V(2); PG8_BAR;
        PG8_STAGE(PG8_SB(1, 0), cB + kstep, voffB); PG8_STAGE(PG8_SA(1, 0), cA + kstep, voffA); PG8_STAGE(PG8_SB(1, 1), cB + hstep + kstep, voffB);
        PG8_WAIT_V(6); PG8_BAR;
    } else {
        PG8_STAGE(PG8_SB(0, 0), cB, voffB); PG8_STAGE(PG8_SA(0, 0), cA, voffA); PG8_STAGE(PG8_SB(0, 1), cB + hstep, voffB); PG8_STAGE(PG8_SA(0, 1), cA + hstep, voffA);
        if (wr == 1) PG8_BAR;
        PG8_WAIT_V(4); PG8_BAR;
        PG8_STAGE(PG8_SB(1, 0), cB + kstep, voffB); PG8_STAGE(PG8_SA(1, 0), cA + kstep, voffA); PG8_STAGE(PG8_SB(1, 1), cB + hstep + kstep, voffB);
        PG8_WAIT_V(6); PG8_BAR;
    }
    for (;;) {
        const bool has_next = S.next(ui + 1, nxt);
        const char* nA = has_next ? (const char*)g.A + (size_t)nxt.pm * tstep : cA; const char* nB = has_next ? (const char*)g.Bt + (size_t)nxt.pn * tstep : cB;
        for (int t = 0; t < nt; t += 2) {
            const bool last = (t == nt - 2);
            const char* a1 = cA + (size_t)(t + 1) * kstep;
            const char* a2 = last ? nA : cA + (size_t)(t + 2) * kstep; const char* b2 = last ? nB : cB + (size_t)(t + 2) * kstep;
            const char* a3 = a2 + kstep; const char* b3 = b2 + kstep;
            if (last && has_next) S.a_ready(nxt);
            if constexpr (SP2) {
            PG8_LDB(B0, 0, 0); PG8_LDB(B1, 0, 1); PG8_SCHED; PG8_LDA(At, 0, 0); PG8_STAGE(PG8_SA(1, 1), a1 + hstep, voffA);
            PG8_WAIT_V(8); PG8_WAIT_L(0); PG8_BAR; PG8_MMA(0, 0, At, B0); PG8_MMA(0, 1, At, B1); PG8_BAR; PG8_SCHED;
            PG8_LDA(At, 0, 1); PG8_STAGE(PG8_SB(0, 0), b2, voffB); PG8_STAGE(PG8_SB(0, 1), b2 + hstep, voffB); PG8_STAGE(PG8_SA(0, 0), a2, voffA);
            PG8_WAIT_V(8); PG8_WAIT_L(0); PG8_BAR; PG8_MMA(1, 0, At, B0); PG8_MMA(1, 1, At, B1); PG8_BAR; PG8_SCHED;
            PG8_LDB(B0, 1, 0); PG8_LDB(B1, 1, 1); PG8_SCHED; PG8_LDA(At, 1, 0); PG8_STAGE(PG8_SA(0, 1), a2 + hstep, voffA);
            PG8_WAIT_V(8); PG8_WAIT_L(0); PG8_BAR; PG8_MMA(0, 0, At, B0); PG8_MMA(0, 1, At, B1); PG8_BAR; PG8_SCHED;
            PG8_LDA(At, 1, 1); PG8_STAGE(PG8_SB(1, 0), b3, voffB); PG8_STAGE(PG8_SB(1, 1), b3 + hstep, voffB); PG8_STAGE(PG8_SA(1, 0), a3, voffA);
            PG8_WAIT_V(8); PG8_WAIT_L(0); PG8_BAR; PG8_MMA(1, 0, At, B0); PG8_MMA(1, 1, At, B1); PG8_BAR; PG8_SCHED;
            } else {
            PG8_LDB(B0, 0, 0); PG8_SCHED; PG8_LDA(At, 0, 0); PG8_STAGE(PG8_SA(1, 1), a1 + hstep, voffA);
            PG8_WAIT_L(8); PG8_BAR; PG8_WAIT_L(0); PG8_MMA(0, 0, At, B0); PG8_BAR; PG8_SCHED;
            PG8_LDB(B1, 0, 1); PG8_STAGE(PG8_SB(0, 0), b2, voffB);
            PG8_BAR; PG8_WAIT_L(0); PG8_MMA(0, 1, At, B1); PG8_BAR;
            PG8_LDA(At, 0, 1); PG8_STAGE(PG8_SA(0, 0), a2, voffA);
            PG8_BAR; PG8_WAIT_L(0); PG8_MMA(1, 0, At, B0); PG8_BAR; PG8_SCHED;
            PG8_STAGE(PG8_SB(0, 1), b2 + hstep, voffB);
            PG8_WAIT_V(6); PG8_BAR; PG8_MMA(1, 1, At, B1); PG8_BAR;
            PG8_LDB(B0, 1, 0); PG8_SCHED; PG8_LDA(At, 1, 0); PG8_STAGE(PG8_SA(0, 1), a2 + hstep, voffA);
            PG8_WAIT_L(8); PG8_BAR; PG8_WAIT_L(0); PG8_MMA(0, 0, At, B0); PG8_BAR; PG8_SCHED;
            PG8_LDB(B1, 1, 1); PG8_STAGE(PG8_SB(1, 0), b3, voffB);
            PG8_BAR; PG8_WAIT_L(0); PG8_MMA(0, 1, At, B1); PG8_BAR;
            PG8_LDA(At, 1, 1); PG8_STAGE(PG8_SA(1, 0), a3, voffA);
            PG8_BAR; PG8_WAIT_L(0); PG8_MMA(1, 0, At, B0); PG8_BAR; PG8_SCHED;
            PG8_STAGE(PG8_SB(1, 1), b3 + hstep, voffB);
            PG8_WAIT_V(6); PG8_BAR; PG8_MMA(1, 1, At, B1); PG8_BAR;
            }
        }
        if constexpr (ALIGN_EPI) { if (wr == 0) PG8_BAR; }
        if constexpr (!Epi::AFTER_DRAIN) { E(acc, cur, wr, wc, fr, fq); S.done(cur); }
        if (!has_next) break;
#pragma unroll
        for (int a = 0; a < 2; ++a)
#pragma unroll
            for (int b = 0; b < 2; ++b)
#pragma unroll
                for (int m = 0; m < 4; ++m)
#pragma unroll
                    for (int n = 0; n < 2; ++n) acc[a][b][m][n] = (f32x4){0.f, 0.f, 0.f, 0.f};
        cur = nxt; cA = nA; cB = nB; ++ui;
        if constexpr (ALIGN_EPI) { if (wr == 1) PG8_BAR; }
    }
    PG8_WAIT_V(0);
    if constexpr (!ALIGN_EPI) { if (wr == 0) PG8_BAR; }
    PG8_BAR;
    if constexpr (Epi::AFTER_DRAIN) { E.fused(acc, cur, wr, wc, fr, fq, lds, wid, lane); S.done(cur); }
#undef PG8_SA
#undef PG8_SB
#undef PG8_STAGE
#undef PG8_LDA
#undef PG8_LDB
#undef PG8_MMA
#undef PG8_WAIT_V
#undef PG8_WAIT_L
#undef PG8_BAR
#undef PG8_SCHED
}
}
#define LAS __attribute__((address_space(3)))
typedef unsigned short bf16;
typedef unsigned u32x4 __attribute__((ext_vector_type(4)));
typedef unsigned u32x2 __attribute__((ext_vector_type(2)));
typedef float f32x4 __attribute__((ext_vector_type(4)));
typedef float f32x16 __attribute__((ext_vector_type(16)));
typedef short bf16x8 __attribute__((ext_vector_type(8)));
typedef short s16x4 __attribute__((ext_vector_type(4)));

constexpr int T = 16384, SEQ = 4096, D = 2048, DEPTH = 4;
constexpr int EV_IN = 6432, EV_IN_P = 6656, OD_IN = 1600, OD_IN_P = 1792, DFF = 5632;
constexpr int LORA_K = 384, LORA_N = 3072, RWKV_IN = 3360;
constexpr float NORM_EPS = 1e-6f, GN_EPS = 64e-5f;
constexpr int NWAVES = 8, NTHREADS = 512;
constexpr int LDS_BYTES = 147456;

constexpr size_t al(size_t x) { return (x + 255) & ~(size_t)255; }
constexpr size_t SZ_EVIN = (size_t)EV_IN_P * D * 2, SZ_EVLORA = (size_t)LORA_N * LORA_K * 2, SZ_WOUT = (size_t)D * D * 2, SZ_ODIN = (size_t)OD_IN_P * D * 2,
                 SZ_POOL = 512 * 512 * 2, SZ_UQ = 2304 * 512 * 2, SZ_UKV = 3072 * 512 * 2;
constexpr size_t WS_EVIN = 0, WS_EVLORA = WS_EVIN + 2 * SZ_EVIN, WS_EVOUT = WS_EVLORA + 2 * SZ_EVLORA, WS_ODIN = WS_EVOUT + 2 * SZ_WOUT,
                 WS_POOL = WS_ODIN + 2 * SZ_ODIN, WS_UQ = WS_POOL + 2 * SZ_POOL, WS_UKV = WS_UQ + 2 * SZ_UQ, WS_ODOUT = WS_UKV + 2 * SZ_UKV,
                 WS_FGU = WS_ODOUT + 2 * SZ_WOUT, WS_FD = WS_FGU + (size_t)2 * DFF * D * 2, SZ_FFN = (size_t)3 * DFF * D * 2, WS_ROPE = WS_FGU + 2 * SZ_FFN,
                 WS_XN = WS_ROPE + (size_t)T * 32 * 8, WS_P = WS_XN + (size_t)T * D * 2, WS_LO = WS_P + (size_t)T * EV_IN_P * 2,
                 WS_AL = WS_LO + (size_t)T * LORA_N * 2, WS_SI = WS_AL + (size_t)T * LORA_K * 2, WS_SW = WS_SI + (size_t)T * 1024 * 8,
                 WS_SV = WS_SW + (size_t)T * 1024 * 4, WS_CTL = WS_SV + (size_t)T * 1024 * 2, CTL_BYTES = 65536, WS_SS = WS_CTL + CTL_BYTES, WS_END = WS_SS + 2 * (size_t)T * 32 * 4;
static_assert((size_t)16384 * 10496 <= (size_t)T * 1024 * 8 + (40u << 20) && (41u << 20) <= (size_t)T * 1024 * 4, "OPS + COEF fit SI|SW");
static_assert(WS_EVLORA % 256 == 0 && WS_ROPE % 256 == 0 && WS_XN % 256 == 0 && WS_SV % 256 == 0, "alignment");

__device__ __forceinline__ float bflo(unsigned w) { return __uint_as_float(w << 16); }
__device__ __forceinline__ float bfhi(unsigned w) { return __uint_as_float(w & 0xffff0000u); }
__device__ __forceinline__ float bf2f(bf16 b) { return __uint_as_float((unsigned)b << 16); }
using pg8::pk_bf16;
__device__ __forceinline__ bf16 f2bf(float f) { return (bf16)(pk_bf16(f, 0.f) & 0xffffu); }
__device__ __forceinline__ void unpack8(const u32x4 w, float (&f)[8]) { f[0] = bflo(w.x); f[1] = bfhi(w.x); f[2] = bflo(w.y); f[3] = bfhi(w.y); f[4] = bflo(w.z); f[5] = bfhi(w.z); f[6] = bflo(w.w); f[7] = bfhi(w.w); }
__device__ __forceinline__ u32x4 pack8(const float (&f)[8]) { u32x4 w; w.x = pk_bf16(f[0], f[1]); w.y = pk_bf16(f[2], f[3]); w.z = pk_bf16(f[4], f[5]); w.w = pk_bf16(f[6], f[7]); return w; }
__device__ __forceinline__ float wave_sum(float v) {
#pragma unroll
    for (int o = 1; o < 64; o <<= 1) v += __shfl_xor(v, o);
    return v;
}
__device__ __forceinline__ float fexp(float x) { return __builtin_amdgcn_exp2f(x * 1.4426950408889634f); }
__device__ __forceinline__ float flog(float x) { return __builtin_amdgcn_logf(x) * 0.6931471805599453f; }
__device__ __forceinline__ float fsigmoid(float x) { return __builtin_amdgcn_rcpf(1.0f + fexp(-x)); }
__device__ __forceinline__ float ftanh(float x) { return 1.0f - 2.0f * __builtin_amdgcn_rcpf(1.0f + fexp(2.0f * x)); }

__device__ __forceinline__ void tr_item(const float* W, int Ksrc, int N, int k0, int n0, bf16* dst, int ldt, int drow0, int dcol0, LAS float* scr, int lane, const float* nscale = nullptr, const float* kscale = nullptr) {
    f32x4 tv[8]; const int kr_ = lane >> 3, nq_ = lane & 7;
#pragma unroll
    for (int i = 0; i < 8; ++i) { const int kk = 8 * i + kr_; const int kr = (k0 + kk < Ksrc) ? (k0 + kk) : (Ksrc - 1); tv[i] = __builtin_nontemporal_load((const f32x4*)(W + (size_t)kr * N + n0 + 4 * nq_)); }
#pragma unroll
    for (int i = 0; i < 8; ++i) { const int kk = 8 * i + kr_; const bool ok = (k0 + kk < Ksrc); LAS float* d_ = scr + kk * 33 + 4 * nq_;
        const float ks_ = (ok && kscale) ? kscale[k0 + kk] : 1.0f;
        d_[0] = ok ? tv[i].x * ks_ : 0.f; d_[1] = ok ? tv[i].y * ks_ : 0.f; d_[2] = ok ? tv[i].z * ks_ : 0.f; d_[3] = ok ? tv[i].w * ks_ : 0.f; }
    asm volatile("s_waitcnt lgkmcnt(0)" ::: "memory");
    const int c = lane & 7;
#pragma unroll
    for (int j = 0; j < 4; ++j) { const int n = (lane >> 3) + 8 * j; const LAS float* s = scr + (8 * c) * 33 + n;
        const float sc = nscale ? nscale[n0 + n] : 1.0f;
        u32x4 o; o.x = pk_bf16(s[0 * 33] * sc, s[1 * 33] * sc); o.y = pk_bf16(s[2 * 33] * sc, s[3 * 33] * sc); o.z = pk_bf16(s[4 * 33] * sc, s[5 * 33] * sc); o.w = pk_bf16(s[6 * 33] * sc, s[7 * 33] * sc);
        *(u32x4*)(dst + (size_t)(drow0 + n) * ldt + dcol0 + k0 + 8 * c) = o; }
    asm volatile("s_waitcnt lgkmcnt(0)" ::: "memory");
}
__device__ __forceinline__ void tr_matrix(const float* W, int Ksrc, int N, bf16* dst, int ldt, int dcol0, int rowmode, int drow_off, LAS float* scr, int gw, int ngw, int lane, const float* nscale = nullptr, const float* kscale = nullptr) {
    const int nkb = (Ksrc + 63) / 64, nnb = N / 32, items = nkb * nnb;
    for (int it = gw; it < items; it += ngw) { const int kb = it / nnb, nb = it - kb * nnb, n0 = nb * 32;
        const int drow0 = rowmode ? ((n0 >> 7) * 256 + (n0 & 127) + drow_off) : (drow_off + n0);
        tr_item(W, Ksrc, N, kb * 64, n0, dst, ldt, drow0, dcol0, scr, lane, nscale, kscale); }
}
__device__ __forceinline__ void zero_fill(void* p, size_t bytes, int gtid, int gthreads) {
    u32x4* q = (u32x4*)p; const size_t n = bytes / 16;
    for (size_t i = gtid; i < n; i += gthreads) q[i] = (u32x4){0u, 0u, 0u, 0u};
}
__device__ __forceinline__ void ld8f(const float* p, float (&f)[8]) { const f32x4 a = *(const f32x4*)p, b = *(const f32x4*)(p + 4); f[0] = a.x; f[1] = a.y; f[2] = a.z; f[3] = a.w; f[4] = b.x; f[5] = b.y; f[6] = b.z; f[7] = b.w; }
__device__ __forceinline__ void zero_lora_pool(bf16* lora_t, bf16* pool_t, int gtid, int gthreads) {
    for (int e = gtid; e < 3072 * 48; e += gthreads) { const int n = e / 48, c = e - n * 48, seg = n >> 10; const int lo = seg == 0 ? 0 : (seg == 1 ? 8 : 16), hi = seg == 0 ? 8 : (seg == 1 ? 16 : 40);
        if (c < lo || c >= hi) *(u32x4*)(lora_t + (size_t)n * 384 + c * 8) = (u32x4){0u, 0u, 0u, 0u}; }
    for (int e = gtid; e < 512 * 64; e += gthreads) { const int r = e >> 6, c = e & 63;
        if ((c >> 4) != (r >> 7)) *(u32x4*)(pool_t + (size_t)r * 512 + c * 8) = (u32x4){0u, 0u, 0u, 0u}; }
}
__device__ __forceinline__ void norm_rows(const float* x32, bf16* h16, bf16* xn, float* fout, const float* g, int gw, int ngw, int lane) {
    for (int m0 = gw; m0 < T; m0 += 2 * ngw) {
        float v[2][4][8];
#pragma unroll
        for (int r = 0; r < 2; ++r) { const int m = m0 + r * ngw;
            if (x32) {
#pragma unroll
                for (int j = 0; j < 4; ++j) { const f32x4 a = *(const f32x4*)(x32 + (size_t)m * D + (64 * j + lane) * 8), b = *(const f32x4*)(x32 + (size_t)m * D + (64 * j + lane) * 8 + 4);
                    v[r][j][0] = a.x; v[r][j][1] = a.y; v[r][j][2] = a.z; v[r][j][3] = a.w; v[r][j][4] = b.x; v[r][j][5] = b.y; v[r][j][6] = b.z; v[r][j][7] = b.w; }
            } else {
#pragma unroll
                for (int j = 0; j < 4; ++j) unpack8(*(const u32x4*)(h16 + (size_t)m * D + (64 * j + lane) * 8), v[r][j]);
            } }
#pragma unroll
        for (int r = 0; r < 2; ++r) { const int m = m0 + r * ngw; float s = 0.f;
            if (x32) {
#pragma unroll
                for (int j = 0; j < 4; ++j) { const u32x4 w = pack8(v[r][j]); *(u32x4*)(h16 + (size_t)m * D + (64 * j + lane) * 8) = w; unpack8(w, v[r][j]); } }
#pragma unroll
            for (int j = 0; j < 4; ++j)
#pragma unroll
                for (int e = 0; e < 8; ++e) s += v[r][j][e] * v[r][j][e];
            s = wave_sum(s);
            const float sc = rsqrtf(s * (1.0f / D) + NORM_EPS);
#pragma unroll
            for (int j = 0; j < 4; ++j) { float gg[8], o[8]; ld8f(g + (64 * j + lane) * 8, gg);
#pragma unroll
                for (int e = 0; e < 8; ++e) o[e] = v[r][j][e] * sc * gg[e];
                if (xn) *(u32x4*)(xn + (size_t)m * D + (64 * j + lane) * 8) = pack8(o);
                if (fout) { float* fp = fout + (size_t)m * D + (64 * j + lane) * 8; *(f32x4*)fp = (f32x4){o[0], o[1], o[2], o[3]}; *(f32x4*)(fp + 4) = (f32x4){o[4], o[5], o[6], o[7]}; } } }
    }
}
__device__ __forceinline__ void init_rows(const float* x32, bf16* h16, float* ssp, int gw, int ngw, int lane) {
    for (int m = gw; m < T; m += ngw) { float s = 0.f;
#pragma unroll
        for (int j = 0; j < 4; ++j) { float v[8]; ld8f(x32 + (size_t)m * D + (64 * j + lane) * 8, v); const u32x4 w = pack8(v); *(u32x4*)(h16 + (size_t)m * D + (64 * j + lane) * 8) = w; unpack8(w, v);
#pragma unroll
            for (int e = 0; e < 8; ++e) s += v[e] * v[e]; }
        s = wave_sum(s);
        if (lane < 32) ssp[(size_t)m * 32 + lane] = (lane == 0) ? s : 0.f; }
}
__device__ __forceinline__ void final_rows(const bf16* h16, const float* ssp, const float* g, float* out, int gw, int ngw, int lane) {
    for (int m = gw; m < T; m += ngw) { float t = 0.f;
#pragma unroll
        for (int i = 0; i < 8; ++i) { const f32x4 q = *(const f32x4*)(ssp + (size_t)m * 32 + 4 * i); t += (q.x + q.y) + (q.z + q.w); }
        const float sc = rsqrtf(t * (1.0f / D) + NORM_EPS);
#pragma unroll
        for (int j = 0; j < 4; ++j) { float v[8], gg[8]; unpack8(*(const u32x4*)(h16 + (size_t)m * D + (64 * j + lane) * 8), v); ld8f(g + (64 * j + lane) * 8, gg);
            float* fp = out + (size_t)m * D + (64 * j + lane) * 8;
            *(f32x4*)fp = (f32x4){v[0] * sc * gg[0], v[1] * sc * gg[1], v[2] * sc * gg[2], v[3] * sc * gg[3]}; *(f32x4*)(fp + 4) = (f32x4){v[4] * sc * gg[4], v[5] * sc * gg[5], v[6] * sc * gg[6], v[7] * sc * gg[7]}; } }
}
__device__ __forceinline__ void rope_table(const int* pos, float* rope, int gtid, int gthreads) {
    for (int e = gtid; e < T * 32; e += gthreads) { const int m = e >> 5, i = e & 31;
        const float inv = exp2f(-(float)i * (13.287712379549449f / 32.0f));
        const float ang = (float)pos[m] * inv;
        const double rev = (double)ang * 0.15915494309189535; const double fr = rev - rint(rev);
        const float a = (float)(fr * 6.283185307179586);
        rope[2 * e] = __cosf(a); rope[2 * e + 1] = __sinf(a); }
}

__device__ __forceinline__ void e2_phase(const bf16* P, const float* convw, const float* mu, bf16* mix, bf16* alora, int gw, int ngw, int lane) {
    for (int m = gw; m < T; m += ngw) { const int t = m & (SEQ - 1); const bf16* pr = P + (size_t)m * EV_IN_P;
#pragma unroll
        for (int i = 0; i < 2; ++i) { const int c = (lane + 64 * i) * 8;
            float bg[8], u0[8], u1[8], u2[8], tmp[8];
            unpack8(*(const u32x4*)(pr + c), bg);
            unpack8(*(const u32x4*)(pr + 1024 + c), u0); unpack8(*(const u32x4*)(pr + 2048 + c), tmp);
#pragma unroll
            for (int e = 0; e < 8; ++e) u0[e] *= tmp[e];
            if (t >= 1) { unpack8(*(const u32x4*)(pr - EV_IN_P + 1024 + c), u1); unpack8(*(const u32x4*)(pr - EV_IN_P + 2048 + c), tmp);
#pragma unroll
                for (int e = 0; e < 8; ++e) u1[e] *= tmp[e]; }
            else {
#pragma unroll
                for (int e = 0; e < 8; ++e) u1[e] = 0.f; }
            if (t >= 2) { unpack8(*(const u32x4*)(pr - 2 * EV_IN_P + 1024 + c), u2); unpack8(*(const u32x4*)(pr - 2 * EV_IN_P + 2048 + c), tmp);
#pragma unroll
                for (int e = 0; e < 8; ++e) u2[e] *= tmp[e]; }
            else {
#pragma unroll
                for (int e = 0; e < 8; ++e) u2[e] = 0.f; }
            float o[8]; const float* cw = convw + c * 3;
#pragma unroll
            for (int e = 0; e < 8; ++e) o[e] = bg[e] * (cw[3 * e + 2] * u0[e] + cw[3 * e + 1] * u1[e] + cw[3 * e] * u2[e]);
            *(u32x4*)(mix + (size_t)m * D + c) = pack8(o); }
#pragma unroll
        for (int i = 0; i < 6; ++i) { const int idx = lane + 64 * i; float val = 0.f;
            if (idx < 288) { const float pt = bf2f(pr[6144 + idx]); const float pp = (t >= 1) ? bf2f(pr[6144 + idx - EV_IN_P]) : 0.f;
                const float xs = pt + (pp - pt) * mu[3072 + idx];
                val = idx < 64 ? ftanh(xs) : (idx < 128 ? xs : fsigmoid(xs)); }
            alora[(size_t)m * LORA_K + idx] = f2bf(val); }
    }
}
__device__ __forceinline__ float sum8(float x) { x += __shfl_xor(x, 1); x += __shfl_xor(x, 2); x += __shfl_xor(x, 4); return x; }
__device__ __forceinline__ void e4_phase(const bf16* P, const bf16* LO, const float* mu, const float* w0, const float* a0, const float* k_k, const float* k_a,
                                         bf16* SI, float* SW, bf16* SV, int gw, int ngw, int lane) {
    const int hf = gw & 1, c = hf * 512 + lane * 8, h = c >> 6, cl = (lane & 7) * 8;
    float mu_r[8], mu_k[8], mu_v[8], w0c[8], a0c[8], kkc[8], kac[8];
    ld8f(mu + c, mu_r); ld8f(mu + 1024 + c, mu_k); ld8f(mu + 2048 + c, mu_v); ld8f(w0 + c, w0c); ld8f(a0 + c, a0c); ld8f(k_k + c, kkc); ld8f(k_a + c, kac);
    for (int m = gw >> 1; m < T; m += ngw >> 1) { const int t = m & (SEQ - 1), b = m >> 12; const bf16* pr = P + (size_t)m * EV_IN_P + 3072 + c;
        float r[8], k[8], v[8], r1[8], k1[8], v1[8], lw[8], la[8];
        unpack8(*(const u32x4*)pr, r); unpack8(*(const u32x4*)(pr + 1024), k); unpack8(*(const u32x4*)(pr + 2048), v);
        unpack8(*(const u32x4*)(LO + (size_t)m * LORA_N + c), lw); unpack8(*(const u32x4*)(LO + (size_t)m * LORA_N + 1024 + c), la);
        { const bf16* pp = (t >= 1) ? (pr - EV_IN_P) : pr; const float z1 = (t >= 1) ? 1.0f : 0.0f;
          unpack8(*(const u32x4*)pp, r1); unpack8(*(const u32x4*)(pp + 1024), k1); unpack8(*(const u32x4*)(pp + 2048), v1);
#pragma unroll
          for (int e = 0; e < 8; ++e) { r1[e] *= z1; k1[e] *= z1; v1[e] *= z1; } }
        float kk[8], kp[8], bb[8], dec[8]; float n2 = 0.f;
#pragma unroll
        for (int e = 0; e < 8; ++e) { r[e] += (r1[e] - r[e]) * mu_r[e]; k[e] += (k1[e] - k[e]) * mu_k[e]; v[e] += (v1[e] - v[e]) * mu_v[e];
            const float z = -(w0c[e] + lw[e]); const float sp = fmaxf(z, 0.f) + flog(1.0f + fexp(-fabsf(z))); const float w = -sp - 0.5f;
            dec[e] = fexp(-fexp(w));
            const float a = fsigmoid(a0c[e] + la[e]);
            kk[e] = k[e] * kkc[e]; n2 += kk[e] * kk[e];
            kp[e] = k[e] * (1.0f + (a - 1.0f) * kac[e]); bb[e] = a; }
        n2 = sum8(n2); const float inn = 1.0f / fmaxf(sqrtf(n2), 1e-12f);
#pragma unroll
        for (int e = 0; e < 8; ++e) { kk[e] *= inn; bb[e] *= kk[e]; }
        const size_t idx = (size_t)(b * 16 + h) * SEQ + t;
        bf16* si = SI + idx * 256 + cl;
        *(u32x4*)si = pack8(kp); *(u32x4*)(si + 64) = pack8(kk); *(u32x4*)(si + 128) = pack8(bb); *(u32x4*)(si + 192) = pack8(r);
        *(f32x4*)(SW + idx * 64 + cl) = (f32x4){dec[0], dec[1], dec[2], dec[3]}; *(f32x4*)(SW + idx * 64 + cl + 4) = (f32x4){dec[4], dec[5], dec[6], dec[7]};
        *(u32x4*)(SV + idx * 64 + cl) = pack8(v);
    }
}
__device__ __forceinline__ void e6_phase(const bf16* LO, const float* COEF, const bf16* SV, const float* ln_w, const float* ln_b, bf16* mix, int gw, int ngw, int lane) {
    const int hf = gw & 1, c = hf * 512 + lane * 8, h = c >> 6, cl = (lane & 7) * 8;
    float lw[8], lb[8]; ld8f(ln_w + c, lw); ld8f(ln_b + c, lb);
    const int step = ngw >> 1;
    for (int m0 = gw >> 1; m0 < T; m0 += 2 * step) {
        u32x4 ry[2], rv[2], rg[2]; float bs[2];
#pragma unroll
        for (int r = 0; r < 2; ++r) { const int m = m0 + r * step, t = m & (SEQ - 1), b = m >> 12; const size_t idx = (size_t)(b * 16 + h) * SEQ + t;
            ry[r] = *(const u32x4*)(mix + (size_t)m * D + 1024 + c); rv[r] = *(const u32x4*)(SV + idx * 64 + cl); rg[r] = *(const u32x4*)(LO + (size_t)m * LORA_N + 2048 + c); bs[r] = COEF[(size_t)m * 16 + h]; }
#pragma unroll
        for (int r = 0; r < 2; ++r) { const int m = m0 + r * step;
            float y[8], v[8], g[8]; unpack8(ry[r], y); unpack8(rv[r], v); unpack8(rg[r], g);
            float s = 0.f;
#pragma unroll
            for (int e = 0; e < 8; ++e) s += y[e];
            s = sum8(s);
            const float mean = s * (1.0f / 64.0f); float q = 0.f;
#pragma unroll
            for (int e = 0; e < 8; ++e) { y[e] -= mean; q += y[e] * y[e]; }
            q = sum8(q); const float rs = rsqrtf(q * (1.0f / 64.0f) + GN_EPS);
            float o[8];
#pragma unroll
            for (int e = 0; e < 8; ++e) o[e] = (y[e] * rs * lw[e] + lb[e] + bs[r] * v[e]) * g[e];
            *(u32x4*)(mix + (size_t)m * D + 1024 + c) = pack8(o); }
    }
}
__device__ __forceinline__ float mul_s(float a, float b) { float r; asm("v_mul_f32_e32 %0, %1, %2" : "=v"(r) : "v"(a), "v"(b)); return r; }
__device__ __forceinline__ float add_s(float a, float b) { float r; asm("v_add_f32_e32 %0, %1, %2" : "=v"(r) : "v"(a), "v"(b)); return r; }
__device__ __forceinline__ float fma_s(float a, float b, float c) { float r; asm("v_fma_f32 %0, %1, %2, %3" : "=v"(r) : "v"(a), "v"(b), "v"(c)); return r; }
__device__ __forceinline__ float fnma_s(float a, float b, float c) { float r; asm("v_fma_f32 %0, -%1, %2, %3" : "=v"(r) : "v"(a), "v"(b), "v"(c)); return r; }
template <int CTRL> __device__ __forceinline__ float dppf(float x) { return __builtin_bit_cast(float, __builtin_amdgcn_update_dpp(0, __builtin_bit_cast(int, x), CTRL, 0xF, 0xF, true)); }
__device__ __forceinline__ float red16(float x) { x += dppf<0xB1>(x); x += dppf<0x4E>(x); x += dppf<0x124>(x); x += dppf<0x128>(x); return x; }
constexpr int SC_CH = 32, SC_STEPF = 336, SC_BUFF = SC_CH * SC_STEPF;
__device__ __forceinline__ void scan_issue(u32x4 (&rsi)[4], f32x4 (&rsw)[2], u32x4& rsv, const bf16* SI, const float* SW, const bf16* SV, size_t ib, int q4, int c, int lt) {
    const size_t t0 = ib + (size_t)c * SC_CH;
#pragma unroll
    for (int i = 0; i < 4; ++i) rsi[i] = *(const u32x4*)(SI + t0 * 256 + (size_t)(lt + 256 * i) * 8);
#pragma unroll
    for (int i = 0; i < 2; ++i) rsw[i] = *(const f32x4*)(SW + t0 * 64 + (size_t)(lt + 256 * i) * 4);
    if (lt < 64) rsv = *(const u32x4*)(SV + (t0 + (lt >> 1)) * 64 + q4 * 16 + (lt & 1) * 8);
}
__device__ __forceinline__ void scan_commit(const u32x4 (&rsi)[4], const f32x4 (&rsw)[2], const u32x4& rsv, LAS float* buf, int lt) {
#pragma unroll
    for (int i = 0; i < 4; ++i) { const int idx = lt + 256 * i, step = idx >> 5, within = idx & 31, vec = within >> 3, e = (within & 7) * 8;
        LAS float* d = buf + step * SC_STEPF + (1 + vec) * 64 + e; float f[8]; unpack8(rsi[i], f);
        *(LAS f32x4*)d = (f32x4){f[0], f[1], f[2], f[3]}; *(LAS f32x4*)(d + 4) = (f32x4){f[4], f[5], f[6], f[7]}; }
#pragma unroll
    for (int i = 0; i < 2; ++i) { const int idx = lt + 256 * i, step = idx >> 4, e = (idx & 15) * 4; *(LAS f32x4*)(buf + step * SC_STEPF + e) = rsw[i]; }
    if (lt < 64) { LAS float* d = buf + (lt >> 1) * SC_STEPF + 320 + (lt & 1) * 8; float f[8]; unpack8(rsv, f);
        *(LAS f32x4*)d = (f32x4){f[0], f[1], f[2], f[3]}; *(LAS f32x4*)(d + 4) = (f32x4){f[4], f[5], f[6], f[7]}; }
}
__device__ __forceinline__ void scan_yout(const LAS float* yb, bf16* mix, int mrow, int colbase, int lt) {
    const int step = lt >> 3, pr = lt & 7;
    const unsigned w = pk_bf16(yb[step * 16 + 2 * pr], yb[step * 16 + 2 * pr + 1]);
    *(unsigned*)(mix + (size_t)(mrow + step) * D + colbase + 2 * pr) = w;
}
__device__ __forceinline__ void scan_phase(LAS unsigned char* lds, const bf16* SI, const float* SW, const bf16* SV, bf16* mix, int bid, int G, int tid) {
    LAS float* buf = (LAS float*)lds; LAS float* ybuf = (LAS float*)(lds + 2 * SC_BUFF * 4);
    const int wid = __builtin_amdgcn_readfirstlane(tid >> 6), lane = tid & 63, lt = tid - 256;
    const bool loader = wid >= 4;
    for (int unit = bid; unit < 256; unit += G) {
        const int bh = unit >> 2, q4 = unit & 3, b = bh >> 4, h = bh & 15;
        const size_t ib = (size_t)bh * SEQ; const int mrow0 = b * SEQ, colbase = 1024 + h * 64 + q4 * 16;
        u32x4 rsi[4]; f32x4 rsw[2]; u32x4 rsv = (u32x4){0u, 0u, 0u, 0u};
        float s0 = 0.f, s1 = 0.f, s2 = 0.f, s3 = 0.f;
        const int rr = lane >> 4, kq = lane & 15, rowl = (wid & 3) * 4 + rr;
        if (loader) { scan_issue(rsi, rsw, rsv, SI, SW, SV, ib, q4, 0, lt); scan_commit(rsi, rsw, rsv, buf, lt); scan_issue(rsi, rsw, rsv, SI, SW, SV, ib, q4, 1, lt); }
        __syncthreads();
        for (int c = 0; c < SEQ / SC_CH; ++c) {
            if (!loader) {
                const LAS float* bb = buf + (c & 1) * SC_BUFF + 4 * kq; LAS float* yb = ybuf + (c & 1) * (SC_CH * 16);
                f32x4 w4 = *(const LAS f32x4*)bb, k4 = *(const LAS f32x4*)(bb + 64), kk4 = *(const LAS f32x4*)(bb + 128), b4 = *(const LAS f32x4*)(bb + 192), r4 = *(const LAS f32x4*)(bb + 256);
                float vv = bb[320 - 4 * kq + rowl];
#pragma unroll 8
                for (int s = 0; s < SC_CH; ++s) { const LAS float* p = bb + (s + 1 < SC_CH ? s + 1 : s) * SC_STEPF;
                    const f32x4 nw = *(const LAS f32x4*)p, nk = *(const LAS f32x4*)(p + 64), nkk = *(const LAS f32x4*)(p + 128), nb = *(const LAS f32x4*)(p + 192), nr = *(const LAS f32x4*)(p + 256);
                    const float nv = p[320 - 4 * kq + rowl];
                    float d = add_s(fma_s(s1, kk4.y, mul_s(s0, kk4.x)), fma_s(s3, kk4.w, mul_s(s2, kk4.z)));
                    const float t0 = fma_s(s0, w4.x, mul_s(vv, k4.x)), t1 = fma_s(s1, w4.y, mul_s(vv, k4.y)), t2 = fma_s(s2, w4.z, mul_s(vv, k4.z)), t3 = fma_s(s3, w4.w, mul_s(vv, k4.w));
                    d = red16(d);
                    s0 = fnma_s(d, b4.x, t0); s1 = fnma_s(d, b4.y, t1); s2 = fnma_s(d, b4.z, t2); s3 = fnma_s(d, b4.w, t3);
                    float y = add_s(fma_s(s1, r4.y, mul_s(s0, r4.x)), fma_s(s3, r4.w, mul_s(s2, r4.z)));
                    y = red16(y);
                    if (kq == 0) yb[s * 16 + rowl] = y;
                    w4 = nw; k4 = nk; kk4 = nkk; b4 = nb; r4 = nr; vv = nv; }
            } else {
                if (c > 0) scan_yout(ybuf + ((c - 1) & 1) * (SC_CH * 16), mix, mrow0 + (c - 1) * SC_CH, colbase, lt);
                if (c + 1 < SEQ / SC_CH) scan_commit(rsi, rsw, rsv, buf + ((c + 1) & 1) * SC_BUFF, lt);
                if (c + 2 < SEQ / SC_CH) scan_issue(rsi, rsw, rsv, SI, SW, SV, ib, q4, c + 2, lt);
            }
            __syncthreads();
        }
        if (loader) scan_yout(ybuf + ((SEQ / SC_CH - 1) & 1) * (SC_CH * 16), mix, mrow0 + (SEQ / SC_CH - 1) * SC_CH, colbase, lt);
        __syncthreads();
    }
}
constexpr int PCI_BYTES = 10496, PC_WAVE_LDS = 16192;
__device__ __forceinline__ u32x4 pack8v(f32x4 lo, f32x4 hi) { u32x4 w; w.x = pk_bf16(lo.x, lo.y); w.y = pk_bf16(lo.z, lo.w); w.z = pk_bf16(hi.x, hi.y); w.w = pk_bf16(hi.z, hi.w); return w; }
__device__ __forceinline__ float wsum_dpp(float x) { x = red16(x);
    return (__builtin_bit_cast(float, __builtin_amdgcn_readlane(__builtin_bit_cast(int, x), 0)) + __builtin_bit_cast(float, __builtin_amdgcn_readlane(__builtin_bit_cast(int, x), 16)))
         + (__builtin_bit_cast(float, __builtin_amdgcn_readlane(__builtin_bit_cast(int, x), 32)) + __builtin_bit_cast(float, __builtin_amdgcn_readlane(__builtin_bit_cast(int, x), 48))); }
__device__ __forceinline__ void pc_phase(LAS unsigned char* lds, const bf16* Pp_, const bf16* LO, const float* mu, const float* w0, const float* a0, const float* k_k, const float* k_a, const float* r_k,
                                         bf16* SV, float* COEF, unsigned char* OPS, int bid, int G, int wave, int lane) {
    LAS bf16* XKK = (LAS bf16*)(lds + wave * PC_WAVE_LDS); LAS bf16* XR = XKK + 1152; LAS bf16* XK = XR + 1152; LAS bf16* XB = XK + 1152;
    LAS float* AKB = (LAS float*)(XB + 1152); LAS float* AKK = AKB + 320; LAS float* ARK = AKK + 272; LAS float* ARB = ARK + 272; LAS float* TT = ARB + 272; LAS float* M1 = TT + 272; LAS float* PCL = M1 + 272;
#define PC_FENCE() asm volatile("s_waitcnt lgkmcnt(0)" ::: "memory")
    const int m = lane & 15, g = lane >> 4; const f32x4 zero = {0.f, 0.f, 0.f, 0.f};
    for (int item = bid * NWAVES + wave; item < 16384; item += G * NWAVES) {
        const size_t ib = (size_t)item * 16;
        const int bh = item >> 8, c = item & 255, b = bh >> 4, h = bh & 15, ch = h * 64 + lane; const int m0 = b * SEQ + c * 16;
        const float mu_r = mu[ch], mu_k = mu[1024 + ch], mu_v = mu[2048 + ch], w0c = w0[ch], a0c = a0[ch], kkc = k_k[ch], kac = k_a[ch], rkc = r_k[ch];
        unsigned short sr_[17], sk_[17], sv_[17], slw[16], sla[16];
        { const bf16* pp = Pp_ + (size_t)(c > 0 ? m0 - 1 : m0) * EV_IN_P + 3072 + ch; sr_[0] = pp[0]; sk_[0] = pp[1024]; sv_[0] = pp[2048]; }
#pragma unroll
        for (int t = 0; t < 16; ++t) { const bf16* pr = Pp_ + (size_t)(m0 + t) * EV_IN_P + 3072 + ch; sr_[t + 1] = pr[0]; sk_[t + 1] = pr[1024]; sv_[t + 1] = pr[2048];
            const bf16* lo = LO + (size_t)(m0 + t) * LORA_N + ch; slw[t] = lo[0]; sla[t] = lo[1024]; }
        const float z1 = (c > 0) ? 1.0f : 0.0f;
        float P = 1.0f, r1 = bf2f(sr_[0]) * z1, k1 = bf2f(sk_[0]) * z1, v1 = bf2f(sv_[0]) * z1;
#pragma unroll
        for (int t = 0; t < 16; ++t) {
            const float r0 = bf2f(sr_[t + 1]), k0 = bf2f(sk_[t + 1]), v0 = bf2f(sv_[t + 1]);
            const float r = r0 + (r1 - r0) * mu_r, k = k0 + (k1 - k0) * mu_k, v = v0 + (v1 - v0) * mu_v; r1 = r0; k1 = k0; v1 = v0;
            const float z = -(w0c + bf2f(slw[t])); const float sp = fmaxf(z, 0.f) + flog(1.0f + fexp(-fabsf(z))); const float w = -sp - 0.5f;
            const float dec = fexp(-fexp(w)); const float a = fsigmoid(a0c + bf2f(sla[t]));
            float kk = k * kkc; const float n2 = wsum_dpp(kk * kk); kk = kk / fmaxf(sqrtf(n2), 1e-12f);
            const float kp = bf2f(f2bf(k * (1.0f + (a - 1.0f) * kac))), bb = bf2f(f2bf(kk * a)), rr = bf2f(f2bf(r)); kk = bf2f(f2bf(kk));
            const float coef = wsum_dpp(rr * kp * rkc);
            SV[(ib + t) * 64 + lane] = f2bf(v);
            if (lane == 0) COEF[(size_t)(m0 + t) * 16 + h] = coef;
            const float Pp = P; P *= dec; const float inv = 1.0f / P;
            XKK[t * 72 + lane] = f2bf(kk * Pp); XR[t * 72 + lane] = f2bf(rr * P); XK[t * 72 + lane] = f2bf(kp * inv); XB[t * 72 + lane] = f2bf(bb * inv); }
        PCL[lane] = P;
        PC_FENCE();
        { f32x4 akb = zero, akk = zero, ark = zero, arb = zero;
#pragma unroll
          for (int ks = 0; ks < 2; ++ks) { const int o = m * 72 + 32 * ks + 8 * g;
              const bf16x8 fkk = *(const LAS bf16x8*)(XKK + o), fr = *(const LAS bf16x8*)(XR + o), fk = *(const LAS bf16x8*)(XK + o), fb = *(const LAS bf16x8*)(XB + o);
              akb = __builtin_amdgcn_mfma_f32_16x16x32_bf16(fkk, fb, akb, 0, 0, 0); akk = __builtin_amdgcn_mfma_f32_16x16x32_bf16(fkk, fk, akk, 0, 0, 0);
              ark = __builtin_amdgcn_mfma_f32_16x16x32_bf16(fr, fk, ark, 0, 0, 0); arb = __builtin_amdgcn_mfma_f32_16x16x32_bf16(fr, fb, arb, 0, 0, 0); }
#pragma unroll
          for (int r = 0; r < 4; ++r) { const int i = 4 * g + r, j = m;
              AKB[i * 20 + j] = (j < i) ? akb[r] : 0.f; AKK[i * 17 + j] = (j < i) ? akk[r] : 0.f; ARK[i * 17 + j] = (j <= i) ? ark[r] : 0.f; ARB[i * 17 + j] = (j <= i) ? arb[r] : 0.f; } }
        PC_FENCE();
        { const int j = m; float Tc[16]; f32x4 Lc[4], Ln[4];
#pragma unroll
          for (int c4 = 0; c4 < 4; ++c4) Lc[c4] = *(const LAS f32x4*)(AKB + 20 + 4 * c4);
          Tc[0] = (j == 0) ? 1.0f : 0.0f;
#pragma unroll
          for (int i = 1; i < 16; ++i) {
              if (i + 1 < 16) {
#pragma unroll
                  for (int c4 = 0; c4 < 4; ++c4) Ln[c4] = *(const LAS f32x4*)(AKB + (i + 1) * 20 + 4 * c4); }
              float a4[4] = {0.f, 0.f, 0.f, 0.f};
#pragma unroll
              for (int mm = 0; mm < i; ++mm) a4[mm & 3] += Lc[mm >> 2][mm & 3] * Tc[mm];
              Tc[i] = ((i == j) ? 1.0f : 0.0f) - ((a4[0] + a4[1]) + (a4[2] + a4[3]));
#pragma unroll
              for (int c4 = 0; c4 < 4; ++c4) Lc[c4] = Ln[c4]; }
#pragma unroll
          for (int i = 0; i < 16; ++i) TT[i * 17 + j] = Tc[i]; }
        PC_FENCE();
#pragma unroll
        for (int q = 0; q < 4; ++q) { const int i = g + 4 * q, j = m; float acc = 0.f;
#pragma unroll
            for (int mm = 0; mm < 16; ++mm) acc += TT[i * 17 + mm] * AKK[mm * 17 + j];
            M1[i * 17 + j] = acc; }
        PC_FENCE();
        { unsigned char* ob = OPS + (size_t)item * PCI_BYTES;
#pragma unroll
          for (int ks = 0; ks < 2; ++ks) { u32x4 w; const LAS u32x2* p0 = (const LAS u32x2*)(XKK + m * 72 + 32 * ks + 4 * g); const LAS u32x2* p1 = (const LAS u32x2*)(XKK + m * 72 + 32 * ks + 16 + 4 * g);
              u32x2 a = *p0, b = *p1; w.x = a.x; w.y = a.y; w.z = b.x; w.w = b.y; *(u32x4*)(ob + ks * 1024 + lane * 16) = w;
              p0 = (const LAS u32x2*)(XR + m * 72 + 32 * ks + 4 * g); p1 = (const LAS u32x2*)(XR + m * 72 + 32 * ks + 16 + 4 * g);
              a = *p0; b = *p1; w.x = a.x; w.y = a.y; w.z = b.x; w.w = b.y; *(u32x4*)(ob + (2 + ks) * 1024 + lane * 16) = w; }
          { f32x4 lo, hi;
#pragma unroll
            for (int j = 0; j < 4; ++j) { lo[j] = TT[m * 17 + 4 * g + j]; hi[j] = M1[m * 17 + 4 * g + j]; }
            *(u32x4*)(ob + 4 * 1024 + lane * 16) = pack8v(lo, hi);
#pragma unroll
            for (int j = 0; j < 4; ++j) { lo[j] = ARK[m * 17 + 4 * g + j]; hi[j] = -ARB[m * 17 + 4 * g + j]; }
            *(u32x4*)(ob + 5 * 1024 + lane * 16) = pack8v(lo, hi); }
#pragma unroll
          for (int kt = 0; kt < 4; ++kt) { const int kcol = 16 * kt + m; const float pc = PCL[kcol]; f32x4 lo, hi;
#pragma unroll
              for (int j = 0; j < 4; ++j) { lo[j] = bf2f(XK[(4 * g + j) * 72 + kcol]) * pc; hi[j] = -bf2f(XB[(4 * g + j) * 72 + kcol]) * pc; }
              *(u32x4*)(ob + (6 + kt) * 1024 + lane * 16) = pack8v(lo, hi); }
          *(float*)(ob + 10240 + lane * 4) = P; }
        PC_FENCE();
    }
#undef PC_FENCE
}
constexpr int SG = 4, SG_OPS = SG * PCI_BYTES, SG_BYTES = SG_OPS + SG * 2048, SG_N16 = SG_BYTES / 16, SG_NL = (SG_N16 + 255) / 256;
typedef float f32x4m __attribute__((ext_vector_type(4)));
__device__ __forceinline__ void sc2_issue(u32x4 (&R)[SG_NL], const unsigned char* ops, const unsigned char* sv, int grp, int lt) {
    if (grp > 63) grp = 63;
    const unsigned char* og = ops + (size_t)grp * SG_OPS; const unsigned char* vg = sv + (size_t)grp * (SG * 2048);
#pragma unroll
    for (int i = 0; i < SG_NL; ++i) { int idx = lt + 256 * i; idx = idx < SG_N16 ? idx : SG_N16 - 1;
        const unsigned char* p = (idx < SG_OPS / 16) ? (og + (size_t)idx * 16) : (vg + (size_t)(idx - SG_OPS / 16) * 16); R[i] = *(const u32x4*)p; }
}
__device__ __forceinline__ void sc2_commit(const u32x4 (&R)[SG_NL], LAS unsigned char* buf, int lt) {
#pragma unroll
    for (int i = 0; i < SG_NL; ++i) { int idx = lt + 256 * i; idx = idx < SG_N16 ? idx : SG_N16 - 1; *(LAS u32x4*)(buf + idx * 16) = R[i]; }
}
__device__ __forceinline__ void sc2_compute(f32x4 (&Z)[4], const LAS unsigned char* buf, bf16* yout, int lane, int vq) {
    const int m = lane & 15, g = lane >> 4; const f32x4 zero = {0.f, 0.f, 0.f, 0.f};
#pragma unroll 1
    for (int ci = 0; ci < SG; ++ci) { const LAS unsigned char* ob = buf + ci * PCI_BYTES + lane * 16;
        const bf16x8 op1_0 = *(const LAS bf16x8*)ob, op1_1 = *(const LAS bf16x8*)(ob + 1024), op3_0 = *(const LAS bf16x8*)(ob + 2048), op3_1 = *(const LAS bf16x8*)(ob + 3072),
                     op2 = *(const LAS bf16x8*)(ob + 4096), op4 = *(const LAS bf16x8*)(ob + 5120);
        const LAS unsigned short* vp = (const LAS unsigned short*)(buf + SG_OPS + ((ci * 16 + 4 * g) * 64 + vq * 16 + m) * 2);
        const short v0 = (short)vp[0], v1 = (short)vp[64], v2 = (short)vp[128], v3 = (short)vp[192];
        const bf16x8 zb0 = __builtin_bit_cast(bf16x8, pack8v(Z[0], Z[1])), zb1 = __builtin_bit_cast(bf16x8, pack8v(Z[2], Z[3]));
        f32x4 Gm = __builtin_amdgcn_mfma_f32_16x16x32_bf16(op1_0, zb0, zero, 0, 0, 0); Gm = __builtin_amdgcn_mfma_f32_16x16x32_bf16(op1_1, zb1, Gm, 0, 0, 0);
        f32x4 Y = __builtin_amdgcn_mfma_f32_16x16x32_bf16(op3_0, zb0, zero, 0, 0, 0); Y = __builtin_amdgcn_mfma_f32_16x16x32_bf16(op3_1, zb1, Y, 0, 0, 0);
        const unsigned g01 = pk_bf16(Gm.x, Gm.y), g23 = pk_bf16(Gm.z, Gm.w);
        bf16x8 B2; B2[0] = (short)(g01 & 0xffff); B2[1] = (short)(g01 >> 16); B2[2] = (short)(g23 & 0xffff); B2[3] = (short)(g23 >> 16); B2[4] = v0; B2[5] = v1; B2[6] = v2; B2[7] = v3;
        const f32x4 U = __builtin_amdgcn_mfma_f32_16x16x32_bf16(op2, B2, zero, 0, 0, 0);
        const unsigned u01 = pk_bf16(U.x, U.y), u23 = pk_bf16(U.z, U.w);
        bf16x8 B3; B3[0] = v0; B3[1] = v1; B3[2] = v2; B3[3] = v3; B3[4] = (short)(u01 & 0xffff); B3[5] = (short)(u01 >> 16); B3[6] = (short)(u23 & 0xffff); B3[7] = (short)(u23 >> 16);
        Y = __builtin_amdgcn_mfma_f32_16x16x32_bf16(op4, B3, Y, 0, 0, 0);
#pragma unroll
        for (int kt = 0; kt < 4; ++kt) { const bf16x8 op5 = *(const LAS bf16x8*)(ob + (6 + kt) * 1024); const f32x4 pc = *(const LAS f32x4*)(buf + ci * PCI_BYTES + 10240 + (16 * kt + 4 * g) * 4);
            Z[kt] = __builtin_amdgcn_mfma_f32_16x16x32_bf16(op5, B3, Z[kt] * pc, 0, 0, 0); }
        bf16* yp = yout + (size_t)(ci * 16 + 4 * g) * D;
        yp[0] = f2bf(Y.x); yp[D] = f2bf(Y.y); yp[2 * D] = f2bf(Y.z); yp[3 * D] = f2bf(Y.w); }
}
__device__ __forceinline__ void scan2_phase(LAS unsigned char* lds, const unsigned char* OPS, const bf16* SV, bf16* mix, int bid, int G, int tid) {
    const int wid = __builtin_amdgcn_readfirstlane(tid >> 6), lane = tid & 63, lt = tid & 255; const bool loader = wid >= 4;
    LAS unsigned char* buf0 = lds; LAS unsigned char* buf1 = lds + SG_BYTES;
    for (int bh = bid; bh < 64; bh += G) { const int b = bh >> 4, h = bh & 15;
        const unsigned char* ops = OPS + (size_t)bh * 256 * PCI_BYTES; const unsigned char* sv = (const unsigned char*)(SV + (size_t)bh * SEQ * 64);
        bf16* ybase = mix + (size_t)(b * SEQ) * D + 1024 + h * 64 + (wid & 3) * 16 + (lane & 15);
        u32x4 ra[SG_NL], rb[SG_NL]; f32x4 Z[4];
#pragma unroll
        for (int kt = 0; kt < 4; ++kt) Z[kt] = (f32x4){0.f, 0.f, 0.f, 0.f};
        if (loader) { sc2_issue(ra, ops, sv, 0, lt); sc2_issue(rb, ops, sv, 1, lt); sc2_commit(ra, buf0, lt); sc2_issue(ra, ops, sv, 2, lt); }
        __syncthreads();
        for (int gi = 0; gi < 64; gi += 2) {
            if (!loader) sc2_compute(Z, buf0, ybase + (size_t)(gi * SG * 16) * D, lane, wid & 3);
            else { sc2_commit(rb, buf1, lt); sc2_issue(rb, ops, sv, gi + 3, lt); }
            __syncthreads();
            if (!loader) sc2_compute(Z, buf1, ybase + (size_t)((gi + 1) * SG * 16) * D, lane, wid & 3);
            else { sc2_commit(ra, buf0, lt); sc2_issue(ra, ops, sv, gi + 4, lt); }
            __syncthreads();
        }
    }
}
__device__ __forceinline__ void o2_phase(const bf16* P, const float* qnorm, const float* kvnorm, const float* rope, bf16* PD, bf16* QN, bf16* KVN, bf16* KPE, int gw, int ngw, int lane) {
    float qg[8], kg[8];
#pragma unroll
    for (int e = 0; e < 8; ++e) { qg[e] = qnorm[lane * 8 + e]; kg[e] = kvnorm[lane * 8 + e]; }
    const int win = 2 << (lane >> 4);
    for (int m = gw; m < T; m += ngw) { const int t = m & (SEQ - 1); const bf16* pr = P + (size_t)m * OD_IN_P;
        { float u[8], acc[8], tmp[8]; unpack8(*(const u32x4*)(pr + lane * 8), u);
#pragma unroll
          for (int e = 0; e < 8; ++e) acc[e] = u[e];
          const int cnt = (t + 1 < win) ? (t + 1) : win;
          for (int j = 1; j < cnt; ++j) { unpack8(*(const u32x4*)(pr - (size_t)j * OD_IN_P + lane * 8), tmp);
#pragma unroll
              for (int e = 0; e < 8; ++e) acc[e] += tmp[e]; }
          const float ic = 1.0f / (float)cnt;
#pragma unroll
          for (int e = 0; e < 8; ++e) acc[e] = acc[e] * ic - u[e];
          *(u32x4*)(PD + (size_t)m * 512 + lane * 8) = pack8(acc); }
        { float q[8]; unpack8(*(const u32x4*)(pr + 512 + lane * 8), q); float s = 0.f;
#pragma unroll
          for (int e = 0; e < 8; ++e) s += q[e] * q[e];
          s = wave_sum(s); const float sc = rsqrtf(s * (1.0f / 512.0f) + NORM_EPS);
#pragma unroll
          for (int e = 0; e < 8; ++e) q[e] = q[e] * sc * qg[e];
          *(u32x4*)(QN + (size_t)m * 512 + lane * 8) = pack8(q); }
        { float q[8]; unpack8(*(const u32x4*)(pr + 1024 + lane * 8), q); float s = 0.f;
#pragma unroll
          for (int e = 0; e < 8; ++e) s += q[e] * q[e];
          s = wave_sum(s); const float sc = rsqrtf(s * (1.0f / 512.0f) + NORM_EPS);
#pragma unroll
          for (int e = 0; e < 8; ++e) q[e] = q[e] * sc * kg[e];
          *(u32x4*)(KVN + (size_t)m * 512 + lane * 8) = pack8(q); }
        { const int i = lane & 31; const float t1 = bf2f(pr[1536 + i]), t2 = bf2f(pr[1568 + i]); const float cs = rope[(size_t)m * 64 + 2 * i], sn = rope[(size_t)m * 64 + 2 * i + 1];
          const float o = (lane < 32) ? (t1 * cs - t2 * sn) : (t1 * sn + t2 * cs);
          KPE[(size_t)m * 64 + lane] = f2bf(o); }
    }
}
__device__ __forceinline__ s16x4 vtr(const LAS unsigned char* p) { typedef short v4i16_t __attribute__((ext_vector_type(4))); return __builtin_bit_cast(s16x4, __builtin_amdgcn_ds_read_tr16_b64_v4i16((LAS v4i16_t*)p)); }
constexpr int AT_KROW = 400, AT_VROW = 320, AT_KB = 64 * AT_KROW, AT_VB = 64 * AT_VROW, AT_BUF = AT_KB + AT_VB;
constexpr int AT_UNITS = 4 * 12 * 16;
__device__ __forceinline__ void attn_phase(LAS unsigned char* lds, const bf16* Q, const bf16* KV, const bf16* KPE, const float* rope, bf16* mix, int bid, int G, int tid) {
    const int wid = __builtin_amdgcn_readfirstlane(tid >> 6);
    const float qs = 0.07216878364870322f * 1.4426950408889634f;
    for (int round = 0; round * G < AT_UNITS; ++round) {
        int idx;
        if (G == 256) { const int i2 = bid >> 1, od = bid & 1;
            idx = (round == 0) ? bid : (round == 1 ? 256 + (od ? 127 - i2 : 255 - i2) : 512 + (od ? 255 - i2 : 127 - i2)); }
        else idx = (round & 1) ? (round * G + (G - 1 - bid)) : (round * G + bid);
        if (idx >= AT_UNITS) continue;
        int tid_r = tid; asm volatile("" : "+v"(tid_r));
        const int lane = tid_r & 63, l32 = lane & 31, hh = lane >> 5;
        const int sr16 = tid_r >> 4, sc16 = tid_r & 15, sr8 = tid_r >> 3, sc8 = tid_r & 7;
        const int qb = 15 - idx / 48, bh = idx % 48, b = bh / 12, h = bh - b * 12;
        const int q0 = qb * 256, mrow0 = b * SEQ, ntiles = (qb + 1) * 4;
        const int qrow = mrow0 + q0 + wid * 32 + l32;
        bf16x8 qf[12];
        { const bf16* qp = Q + (size_t)qrow * 2304 + h * 192 + hh * 8; const float* rp = rope + (size_t)qrow * 64;
#pragma unroll
          for (int ks = 0; ks < 8; ++ks) { float f[8]; unpack8(*(const u32x4*)(qp + ks * 16), f);
#pragma unroll
              for (int e = 0; e < 8; ++e) f[e] *= qs;
              qf[ks] = __builtin_bit_cast(bf16x8, pack8(f)); if (ks & 1) asm volatile("" ::: "memory"); }
#pragma unroll
          for (int ks = 8; ks < 10; ++ks) { float f1[8], f2[8], o1[8], o2[8]; unpack8(*(const u32x4*)(qp + ks * 16), f1); unpack8(*(const u32x4*)(qp + (ks + 2) * 16), f2);
#pragma unroll
              for (int e = 0; e < 8; ++e) { const int i = (ks - 8) * 16 + hh * 8 + e; const float cs = rp[2 * i], sn = rp[2 * i + 1];
                  o1[e] = (f1[e] * cs - f2[e] * sn) * qs; o2[e] = (f1[e] * sn + f2[e] * cs) * qs; }
              qf[ks] = __builtin_bit_cast(bf16x8, pack8(o1)); qf[ks + 2] = __builtin_bit_cast(bf16x8, pack8(o2)); asm volatile("" ::: "memory"); } }
        f32x16 O[4];
#pragma unroll
        for (int i = 0; i < 4; ++i)
#pragma unroll
            for (int e = 0; e < 16; ++e) O[i][e] = 0.f;
        float mrun = -1e30f, lrun = 0.f;
        u32x4 sk[3], sv[2];
        const char* kvb = (const char*)(KV + (size_t)mrow0 * 3072 + h * 256); const char* kpb = (const char*)(KPE + (size_t)mrow0 * 64);
        const unsigned kvo = (unsigned)(sr16 * 3072 + sc16 * 8) * 2u, kpo = (unsigned)(sr8 * 64 + sc8 * 8) * 2u;
#define AT_ISSUE(kt) do { const char* p_ = kvb + (size_t)(kt) * (64 * 3072 * 2); const char* q_ = kpb + (size_t)(kt) * (64 * 64 * 2); \
        sk[0] = *(const u32x4*)(p_ + kvo); sk[1] = *(const u32x4*)(p_ + (kvo + 32u * 3072u * 2u)); sv[0] = *(const u32x4*)(p_ + (kvo + 256u)); sv[1] = *(const u32x4*)(p_ + (kvo + 32u * 3072u * 2u + 256u)); \
        sk[2] = *(const u32x4*)(q_ + kpo); } while (0)
#define AT_COMMIT(bufp) do { LAS unsigned char* b_ = (bufp); \
        *(LAS u32x4*)(b_ + sr16 * AT_KROW + sc16 * 16) = sk[0]; *(LAS u32x4*)(b_ + (sr16 + 32) * AT_KROW + sc16 * 16) = sk[1]; \
        *(LAS u32x4*)(b_ + sr8 * AT_KROW + 256 + sc8 * 16) = sk[2]; \
        *(LAS u32x4*)(b_ + AT_KB + sr16 * AT_VROW + sc16 * 16) = sv[0]; *(LAS u32x4*)(b_ + AT_KB + (sr16 + 32) * AT_VROW + sc16 * 16) = sv[1]; } while (0)
        AT_ISSUE(0); AT_COMMIT(lds);
        __syncthreads();
        const int qlo = q0 + wid * 32;
        for (int kt = 0; kt < ntiles; ++kt) {
            if (kt + 1 < ntiles) AT_ISSUE(kt + 1);
            const int key0 = kt * 64;
            const LAS unsigned char* kb_ = lds + (kt & 1) * AT_BUF; const LAS unsigned char* vb_ = kb_ + AT_KB;
            if (key0 <= qlo + 31) {
                f32x16 S0, S1;
#pragma unroll
                for (int e = 0; e < 16; ++e) { S0[e] = 0.f; S1[e] = 0.f; }
                const LAS unsigned char* ka = kb_ + l32 * AT_KROW + hh * 16;
                bf16x8 kf[2][4];
#define AT_LDK(buf, grp) do { _Pragma("unroll") for (int q_ = 0; q_ < 2; ++q_) { kf[buf][2 * q_] = *(const LAS bf16x8*)(ka + ((grp) * 2 + q_) * 32); kf[buf][2 * q_ + 1] = *(const LAS bf16x8*)(ka + 32 * AT_KROW + ((grp) * 2 + q_) * 32); } } while (0)
                AT_LDK(0, 0); __builtin_amdgcn_sched_barrier(0);
#pragma unroll
                for (int grp = 0; grp < 6; ++grp) {
                    if (grp < 5) { AT_LDK((grp + 1) & 1, grp + 1); }
                    __builtin_amdgcn_sched_barrier(0);
                    __builtin_amdgcn_s_setprio(1);
#pragma unroll
                    for (int q_ = 0; q_ < 2; ++q_) {
                        S0 = __builtin_amdgcn_mfma_f32_32x32x16_bf16(kf[grp & 1][2 * q_], qf[grp * 2 + q_], S0, 0, 0, 0);
                        S1 = __builtin_amdgcn_mfma_f32_32x32x16_bf16(kf[grp & 1][2 * q_ + 1], qf[grp * 2 + q_], S1, 0, 0, 0); }
                    __builtin_amdgcn_s_setprio(0);
                    __builtin_amdgcn_sched_barrier(0); }
#undef AT_LDK
                const LAS unsigned char* va = vb_ + (4 * hh + ((lane & 15) >> 2)) * AT_VROW + (16 * ((lane >> 4) & 1) + 4 * (lane & 3)) * 2;
                s16x4 vf[2][4];
#define AT_LDV(buf, hs) do { const LAS unsigned char* vp_ = va + ((((hs) >> 1) >> 1) * 32 + 16 * (((hs) >> 1) & 1)) * AT_VROW + ((hs) & 1) * 128; _Pragma("unroll") for (int d_ = 0; d_ < 2; ++d_) { vf[buf][2 * d_] = vtr(vp_ + d_ * 64); vf[buf][2 * d_ + 1] = vtr(vp_ + 8 * AT_VROW + d_ * 64); } } while (0)
                AT_LDV(0, 0); __builtin_amdgcn_sched_barrier(0);
                if (key0 + 63 > qlo) { const int qq = qlo + l32;
#pragma unroll
                    for (int e = 0; e < 16; ++e) { const int key = key0 + 8 * (e >> 2) + 4 * hh + (e & 3);
                        if (key > qq) S0[e] = -1e30f; if (key + 32 > qq) S1[e] = -1e30f; } }
                float mx = fmaxf(S0[0], S1[0]);
#pragma unroll
                for (int e = 1; e < 16; ++e) mx = fmaxf(mx, fmaxf(S0[e], S1[e]));
                mx = fmaxf(mx, __shfl_xor(mx, 32));
                const float mnew = (mx > mrun + 6.0f) ? mx : mrun;
                const float alpha = __builtin_amdgcn_exp2f(mrun - mnew); mrun = mnew;
                float rs = 0.f;
#pragma unroll
                for (int e = 0; e < 16; ++e) { S0[e] = __builtin_amdgcn_exp2f(S0[e] - mnew); S1[e] = __builtin_amdgcn_exp2f(S1[e] - mnew); rs += S0[e] + S1[e]; }
                lrun = lrun * alpha + rs;
                if (__builtin_amdgcn_ballot_w64(alpha != 1.0f) != 0ull) {
#pragma unroll
                    for (int i = 0; i < 4; ++i)
#pragma unroll
                        for (int e = 0; e < 16; ++e) O[i][e] *= alpha; }
#pragma unroll
                for (int hs = 0; hs < 8; ++hs) { const int st = hs >> 1;
                    if (hs < 7) { AT_LDV((hs + 1) & 1, hs + 1); }
                    __builtin_amdgcn_sched_barrier(0);
                    float pf[8];
#pragma unroll
                    for (int e = 0; e < 8; ++e) pf[e] = (st >> 1) ? S1[8 * (st & 1) + e] : S0[8 * (st & 1) + e];
                    const bf16x8 pb = __builtin_bit_cast(bf16x8, pack8(pf));
#pragma unroll
                    for (int d_ = 0; d_ < 2; ++d_) { const int dvt = (hs & 1) * 2 + d_; const s16x4 lo = vf[hs & 1][2 * d_], hi = vf[hs & 1][2 * d_ + 1];
                        const bf16x8 A = (bf16x8){lo[0], lo[1], lo[2], lo[3], hi[0], hi[1], hi[2], hi[3]};
                        __builtin_amdgcn_s_setprio(1); O[dvt] = __builtin_amdgcn_mfma_f32_32x32x16_bf16(A, pb, O[dvt], 0, 0, 0); __builtin_amdgcn_s_setprio(0); }
                    __builtin_amdgcn_sched_barrier(0); }
#undef AT_LDV
            }
            if (kt + 1 < ntiles) AT_COMMIT(lds + ((kt + 1) & 1) * AT_BUF);
            __syncthreads();
        }
#undef AT_ISSUE
#undef AT_COMMIT
        const float ltot = lrun + __shfl_xor(lrun, 32); const float inv = 1.0f / ltot;
        bf16* op = mix + (size_t)qrow * D + 512 + h * 128 + 4 * hh;
#pragma unroll
        for (int dvt = 0; dvt < 4; ++dvt)
#pragma unroll
            for (int g4 = 0; g4 < 4; ++g4) { u32x2 w; w.x = pk_bf16(O[dvt][4 * g4] * inv, O[dvt][4 * g4 + 1] * inv); w.y = pk_bf16(O[dvt][4 * g4 + 2] * inv, O[dvt][4 * g4 + 3] * inv);
                *(u32x2*)(op + dvt * 32 + 8 * g4) = w; }
    }
}
#define XB_TMO      128
#define XB_XCNT(j)  (256  + 64 * (j))
#define XB_XSUB(j)  (1280 + 64 * (j))
#define XB_XGEN(j)  (2304 + 64 * (j))
#define XB_TOP      3328
#define XB_TOPGEN   3392
#define XCD_BAR_WORDS 3456
#define XB_SPIN_CAP (1u << 18)

__device__ __forceinline__ unsigned xb_ld(unsigned* p)              { return __hip_atomic_load(p, __ATOMIC_RELAXED, __HIP_MEMORY_SCOPE_AGENT); }
__device__ __forceinline__ unsigned xb_add(unsigned* p, unsigned v) { return __hip_atomic_fetch_add(p, v, __ATOMIC_RELAXED, __HIP_MEMORY_SCOPE_AGENT); }
__device__ __forceinline__ unsigned xb_xcc_id() { return (unsigned)__builtin_amdgcn_s_getreg((3 << 11) | 20) & 0xFu; }
#define XB_SPIN(cond, bar) do { unsigned _sp = 0; while (cond) { __builtin_amdgcn_s_sleep(1); \
    if ((++_sp & 255u) == 0u) { if (xb_ld(&(bar)[XB_TMO])) break; if (_sp > XB_SPIN_CAP) { atomicAdd(&(bar)[XB_TMO], 1u); break; } } } } while (0)

struct XcdBarrier {
    unsigned* bar; unsigned x;
    volatile __attribute__((address_space(3))) unsigned* st;
};

__device__ __forceinline__ XcdBarrier xcd_barrier_post(unsigned* bar, volatile __attribute__((address_space(3))) unsigned* st) {
    XcdBarrier b; b.bar = bar; b.x = xb_xcc_id(); b.st = st;
    if (threadIdx.x == 0) (void)xb_add(&bar[XB_XCNT(b.x)], 1u);
    return b;
}
__device__ __forceinline__ void xcd_barrier_complete(unsigned* bar, unsigned x, unsigned& nloc, unsigned& nx) {
    const unsigned G = gridDim.x * gridDim.y * gridDim.z;
    unsigned sum, cnt, mine, sp = 0u;
    for (;;) {
        sum = 0u; cnt = 0u; mine = 0u;
#pragma unroll
        for (unsigned j = 0; j < 16; ++j) { const unsigned c = xb_ld(&bar[XB_XCNT(j)]); sum += c; cnt += (c > 0u) ? 1u : 0u; mine = (j == x) ? c : mine; }
        if (sum == G) break;
        __builtin_amdgcn_s_sleep(1);
        if ((++sp & 255u) == 0u) { if (xb_ld(&bar[XB_TMO])) break; if (sp > XB_SPIN_CAP) { atomicAdd(&bar[XB_TMO], 1u); break; } }
    }
    nloc = mine > 0u ? mine : 1u; nx = cnt > 0u ? cnt : 1u;
}

__device__ __forceinline__ void xcd_barrier(const XcdBarrier& b) {
    asm volatile("s_waitcnt vmcnt(0)" ::: "memory");
    __syncthreads();
    if (threadIdx.x == 0) {
        unsigned* bar = b.bar;
        __builtin_amdgcn_s_waitcnt(0);
        unsigned nloc = b.st[0], nx = b.st[1];
        if (nloc == 0u) { xcd_barrier_complete(bar, b.x, nloc, nx); b.st[0] = nloc; b.st[1] = nx; }
        const unsigned old = xb_add(&bar[XB_XSUB(b.x)], 1u);
        const unsigned gen = old / nloc;
        if (old + 1u == (gen + 1u) * nloc) {
            __builtin_amdgcn_fence(__ATOMIC_RELEASE, "agent");
            asm volatile("s_waitcnt vmcnt(0)" ::: "memory");
            const unsigned og = xb_add(&bar[XB_TOP], 1u);
            const unsigned tg = og / nx;
            if (og + 1u == (tg + 1u) * nx) xb_add(&bar[XB_TOPGEN], 1u);
            else XB_SPIN(xb_ld(&bar[XB_TOPGEN]) == tg, bar);
            __builtin_amdgcn_fence(__ATOMIC_ACQUIRE, "agent");
            xb_add(&bar[XB_XGEN(b.x)], 1u);
            asm volatile("s_waitcnt vmcnt(0)" ::: "memory");
        } else {
            XB_SPIN(xb_ld(&bar[XB_XGEN(b.x)]) == gen, bar);
            __builtin_amdgcn_fence(__ATOMIC_ACQUIRE, "agent");
            asm volatile("s_waitcnt vmcnt(0)" ::: "memory");
        }
    }
    __syncthreads();
}

__device__ __forceinline__ const float* uniform_ptr(const float* p) { const unsigned long long v = (unsigned long long)p;
    const unsigned lo = __builtin_amdgcn_readfirstlane((unsigned)v), hi = __builtin_amdgcn_readfirstlane((unsigned)(v >> 32)); return (const float*)(((unsigned long long)hi << 32) | lo); }
struct Args { const void* in[31]; float* out; unsigned char* ws; int ph_lo, ph_hi; };
constexpr int NPH = 34;

__global__ void __launch_bounds__(NTHREADS, 2) trunk_fwd(Args a) {
    extern __shared__ __attribute__((aligned(16))) unsigned char lds_raw[];
    LAS unsigned char* lds = (LAS unsigned char*)lds_raw;
    cg::grid_group grid = cg::this_grid();
    volatile LAS unsigned* misc = (volatile LAS unsigned*)(lds + 131072 + 1024);
    if (threadIdx.x < 16) misc[threadIdx.x] = 0u;
    __syncthreads();
    XcdBarrier xbar = xcd_barrier_post((unsigned*)(a.ws + WS_CTL), misc + 8);
    { volatile LAS unsigned long long* tab = (volatile LAS unsigned long long*)(lds + 131072 + 2048);
    if (threadIdx.x == 0) {
#define TB(i) tab[i] = (unsigned long long)a.in[i];
        TB(0) TB(1) TB(2) TB(3) TB(4) TB(5) TB(6) TB(7) TB(8) TB(9) TB(10) TB(11) TB(12) TB(13) TB(14) TB(15) TB(16) TB(17) TB(18) TB(19) TB(20)
        TB(21) TB(22) TB(23) TB(24) TB(25) TB(26) TB(27) TB(28) TB(29) TB(30)
#undef TB
    }
    }
    __syncthreads();
#define INF(i) uniform_ptr((const float*)tab[i])
#ifndef REPSEL
#define REPSEL 0
#endif
    for (int vph = a.ph_lo * 2; vph < a.ph_hi * 2; ++vph) {
        const int ph = vph >> 1;
        int kind, L = 0;
        if (ph < 1) kind = 100;
        else { int r = ph - 1; if (r >= 32) { kind = 30; L = 3; } else { if (r >= 16) { r -= 16; L = 2; } if (r >= 9) { r -= 9; L += 1; }
               kind = (L & 1) ? (r < 5 ? 20 + r : 21 + r) : (r < 3 ? r : (r == 3 ? 11 : (r < 7 ? r : r + 1))); } }
        if (vph & 1) {
            bool sel = false;
            if (REPSEL == 1 && (kind == 0 || kind == 2 || kind == 20 || kind == 22 || kind == 8 || kind == 26)) sel = true;
            if (REPSEL == 2 && kind == 23) sel = true;
            if (REPSEL == 3 && kind == 4) sel = true;
            if (REPSEL == 4 && (kind == 1 || kind == 3 || kind == 21 || kind == 7 || kind == 25 || ((kind == 10 || kind == 28) && L + 1 < DEPTH))) sel = true;
            if (REPSEL == 9 && kind == 11) sel = true;
            if (REPSEL == 10 && (kind == 7 || kind == 25 || ((kind == 10 || kind == 28) && L + 1 < DEPTH))) sel = true;
            if (REPSEL == 11 && kind == 3) sel = true;
            if (REPSEL == 6 && kind == 101) sel = true;
            if (REPSEL == 7 && (kind == 1 || kind == 21)) sel = true;
            if (REPSEL == 8 && (kind == 3 || kind == 5)) sel = true;
            if (REPSEL == 5) xcd_barrier(xbar);
            if (!sel) continue;
        }
        if (vph > a.ph_lo * 2) { if (a.ph_hi < 0) grid.sync(); xcd_barrier(xbar); }
        int tid = threadIdx.x; asm volatile("" : "+v"(tid));
        unsigned tb_ = 131072 + 2048; asm volatile("" : "+s"(tb_));
        volatile LAS unsigned long long* tab = (volatile LAS unsigned long long*)(lds + tb_);
        unsigned char* ws = a.ws; asm volatile("" : "+s"(ws));
        float* OUT = a.out; asm volatile("" : "+s"(OUT));
        const int lane = tid & 63, wave = __builtin_amdgcn_readfirstlane(tid >> 6);
        const int bid = blockIdx.x, G = gridDim.x, gw = bid * NWAVES + wave, ngw = G * NWAVES, gtid = bid * NTHREADS + tid, gthreads = G * NTHREADS;
        bf16* H = (bf16*)(ws + WS_XN); bf16* MIX = (bf16*)OUT; float* SSA = (float*)(ws + WS_SS); float* SSB = SSA + (size_t)T * 32;
        bf16* P = (bf16*)(ws + WS_P); bf16* ACT = P;
        bf16* LO = (bf16*)(ws + WS_LO); bf16* QB = LO;
        bf16* AL = (bf16*)(ws + WS_AL); bf16* KPE = AL;
        bf16* SI = (bf16*)(ws + WS_SI); bf16* KVB = SI;
        float* SW = (float*)(ws + WS_SW); bf16* PD = (bf16*)(ws + WS_SW); bf16* QN = PD + (size_t)T * 512; bf16* KVN = QN + (size_t)T * 512;
        bf16* SV = (bf16*)(ws + WS_SV);
        float* ROPE = (float*)(ws + WS_ROPE);
        bf16* FGU = (bf16*)(ws + WS_FGU + (size_t)(L & 1) * SZ_FFN); bf16* FD = (bf16*)(ws + WS_FD + (size_t)(L & 1) * SZ_FFN);
        LAS float* scr = (LAS float*)(lds + wave * 8448);
        const int j = L >> 1;
        int gsel = -1;
        if (kind == 0 || kind == 2 || kind == 20 || kind == 22) gsel = 0;
        else if (kind == 6 || kind == 9 || kind == 24 || kind == 27) gsel = 1;
        else if (kind == 8 || kind == 26) gsel = 2;
        if (kind == 100) {
            for (int jj = 0; jj < 2; ++jj) {
                zero_lora_pool((bf16*)(ws + WS_EVLORA + jj * SZ_EVLORA), (bf16*)(ws + WS_POOL + jj * SZ_POOL), gtid, gthreads);
                zero_fill(ws + WS_EVIN + jj * SZ_EVIN + (size_t)EV_IN * D * 2, (size_t)(EV_IN_P - EV_IN) * D * 2, gtid, gthreads);
                zero_fill(ws + WS_ODIN + jj * SZ_ODIN + (size_t)OD_IN * D * 2, (size_t)(OD_IN_P - OD_IN) * D * 2, gtid, gthreads);
            }
            rope_table((const int*)INF(1), ROPE, gtid, gthreads);
            init_rows(INF(0), H, SSB, gw, ngw, lane);
            for (int jj = 0; jj < 2; ++jj) {
                tr_matrix(INF(3) + (size_t)jj * D * EV_IN, D, EV_IN, (bf16*)(ws + WS_EVIN + jj * SZ_EVIN), D, 0, 0, 0, scr, gw, ngw, lane, nullptr, INF(2) + (size_t)jj * D);
                bf16* lt_ = (bf16*)(ws + WS_EVLORA + jj * SZ_EVLORA);
                tr_matrix(INF(7) + (size_t)jj * 64 * 1024, 64, 1024, lt_, LORA_K, 0, 0, 0, scr, gw, ngw, lane);
                tr_matrix(INF(9) + (size_t)jj * 64 * 1024, 64, 1024, lt_, LORA_K, 64, 0, 1024, scr, gw, ngw, lane);
                tr_matrix(INF(10) + (size_t)jj * 160 * 1024, 160, 1024, lt_, LORA_K, 128, 0, 2048, scr, gw, ngw, lane);
                tr_matrix(INF(16) + (size_t)jj * D * D, D, D, (bf16*)(ws + WS_EVOUT + jj * SZ_WOUT), D, 0, 0, 0, scr, gw, ngw, lane);
                tr_matrix(INF(18) + (size_t)jj * D * OD_IN, D, OD_IN, (bf16*)(ws + WS_ODIN + jj * SZ_ODIN), D, 0, 0, 0, scr, gw, ngw, lane, nullptr, INF(17) + (size_t)jj * D);
                for (int g = 0; g < 4; ++g)
                    tr_matrix(INF(19) + ((size_t)jj * 4 + g) * 128 * 128, 128, 128, (bf16*)(ws + WS_POOL + jj * SZ_POOL), 512, g * 128, 0, g * 128, scr, gw, ngw, lane, INF(20) + (size_t)jj * 512 + g * 128);
                tr_matrix(INF(22) + (size_t)jj * 512 * 2304, 512, 2304, (bf16*)(ws + WS_UQ + jj * SZ_UQ), 512, 0, 0, 0, scr, gw, ngw, lane);
                tr_matrix(INF(24) + (size_t)jj * 512 * 3072, 512, 3072, (bf16*)(ws + WS_UKV + jj * SZ_UKV), 512, 0, 0, 0, scr, gw, ngw, lane);
                tr_matrix(INF(25) + (size_t)jj * D * D, D, D, (bf16*)(ws + WS_ODOUT + jj * SZ_WOUT), D, 0, 0, 0, scr, gw, ngw, lane);
            }
        }
        if (kind == 30) final_rows(H, SSB, INF(30), OUT, gw, ngw, lane);
        if (gsel == 0) {
            const bool part = (kind == 22 && G == 256);
            const int ng = (kind == 22 && !part) ? 3 : 1;
            for (int gq = 0; gq < ng; ++gq) {
                int gi = gq, Gs = G, cs = bid;
                if (part) { if (bid < 24) { gi = 0; Gs = 24; } else if (bid < 120) { gi = 1; Gs = 96; cs = bid - 24; } else { gi = 2; Gs = 136; cs = bid - 120; } }
                pg8::Gemm g; pg8::EpiStore E;
                if (kind == 0) { g = pg8::Gemm{H, (const bf16*)(ws + WS_EVIN + j * SZ_EVIN), T, EV_IN_P, D}; E = pg8::EpiStore{P, EV_IN_P, SSB}; }
                else if (kind == 2) { g = pg8::Gemm{AL, (const bf16*)(ws + WS_EVLORA + j * SZ_EVLORA), T, LORA_N, LORA_K}; E = pg8::EpiStore{LO, LORA_N, nullptr}; }
                else if (kind == 20) { g = pg8::Gemm{H, (const bf16*)(ws + WS_ODIN + j * SZ_ODIN), T, OD_IN_P, D}; E = pg8::EpiStore{P, OD_IN_P, SSB}; }
                else if (gi == 0) { g = pg8::Gemm{PD, (const bf16*)(ws + WS_POOL + j * SZ_POOL), T, 512, 512}; E = pg8::EpiStore{MIX, D, nullptr}; }
                else if (gi == 1) { g = pg8::Gemm{QN, (const bf16*)(ws + WS_UQ + j * SZ_UQ), T, 2304, 512}; E = pg8::EpiStore{QB, 2304, nullptr}; }
                else { g = pg8::Gemm{KVN, (const bf16*)(ws + WS_UKV + j * SZ_UKV), T, 3072, 512}; E = pg8::EpiStore{KVB, 3072, nullptr}; }
                pg8::StaticOrder S; S.init(g.M, g.N, Gs, cs);
                pg8::gemm_phase<pg8::EpiStore, pg8::StaticOrder, true, true>(lds, g, S, E);
            }
        } else if (gsel == 1) {
            pg8::Gemm g;
            if (kind == 6) g = pg8::Gemm{MIX, (const bf16*)(ws + WS_EVOUT + j * SZ_WOUT), T, D, D};
            else if (kind == 24) g = pg8::Gemm{MIX, (const bf16*)(ws + WS_ODOUT + j * SZ_WOUT), T, D, D};
            else g = pg8::Gemm{ACT, FD, T, D, DFF};
            pg8::EpiResid E{H, D, (kind == 6 || kind == 24) ? SSA : SSB};
            pg8::StaticOrder S; S.init(g.M, g.N, G, bid);
            pg8::gemm_phase<pg8::EpiResid, pg8::StaticOrder, true, true>(lds, g, S, E);
        } else if (gsel == 2) {
            pg8::Gemm g{H, FGU, T, 2 * DFF, D}; pg8::EpiSwiglu E{ACT, DFF, SSA};
            pg8::StaticOrder S; S.init(g.M, g.N, G, bid);
            pg8::gemm_phase<pg8::EpiSwiglu, pg8::StaticOrder, true, true>(lds, g, S, E);
        } else if (kind == 1) {
            e2_phase(P, INF(4) + (size_t)j * 1024 * 3, INF(5) + (size_t)j * RWKV_IN, MIX, AL, gw, ngw, lane);
        } else if (kind == 3) {
            e4_phase(P, LO, INF(5) + (size_t)j * RWKV_IN, INF(6) + (size_t)j * 1024, INF(8) + (size_t)j * 1024, INF(11) + (size_t)j * 1024, INF(12) + (size_t)j * 1024, SI, SW, SV, gw, ngw, lane);
        } else if (kind == 4) {
            if (bid < 64) scan2_phase(lds, (const unsigned char*)SI, SV, MIX, bid, G, tid);
            else {
                const int cw = (bid - 64) * NWAVES + wave, ncw = (G - 64) * NWAVES;
                for (int q = 0; q < 2; ++q) { const int LL = L + q; bf16* fgu = (bf16*)(ws + WS_FGU + (size_t)(LL & 1) * SZ_FFN); bf16* fd = (bf16*)(ws + WS_FD + (size_t)(LL & 1) * SZ_FFN);
                    tr_matrix(INF(27) + (size_t)LL * D * DFF, D, DFF, fgu, D, 0, 1, 0, scr, cw, ncw, lane, nullptr, INF(26) + (size_t)LL * D);
                    tr_matrix(INF(28) + (size_t)LL * D * DFF, D, DFF, fgu, D, 0, 1, 128, scr, cw, ncw, lane, nullptr, INF(26) + (size_t)LL * D);
                    tr_matrix(INF(29) + (size_t)LL * DFF * D, DFF, D, fd, DFF, 0, 0, 0, scr, cw, ncw, lane); }
            }
        } else if (kind == 11) {
            pc_phase(lds, P, LO, INF(5) + (size_t)j * RWKV_IN, INF(6) + (size_t)j * 1024, INF(8) + (size_t)j * 1024, INF(11) + (size_t)j * 1024, INF(12) + (size_t)j * 1024, INF(13) + (size_t)j * 1024,
                     SV, SW + (40u << 20) / 4, (unsigned char*)SI, bid, G, wave, lane);
        } else if (kind == 5) {
            e6_phase(LO, SW + (40u << 20) / 4, SV, INF(14) + (size_t)j * 1024, INF(15) + (size_t)j * 1024, MIX, gw, ngw, lane);
        } else if (kind == 21) {
            o2_phase(P, INF(21) + (size_t)j * 512, INF(23) + (size_t)j * 512, ROPE, PD, QN, KVN, KPE, gw, ngw, lane);
        } else if (kind == 23) {
            attn_phase(lds, QB, KVB, KPE, ROPE, MIX, bid, G, tid);
        }
    }
#undef INF
}

extern "C" void kernel_launch(void* const* d_in, const int* in_sizes, int n_in, void* d_out, int out_size, void* d_ws, size_t ws_size, hipStream_t stream) {
    static int grid = 0;
    if (grid == 0) {
        if (n_in != 31 || out_size != T * D || ws_size < WS_END) { fprintf(stderr, "kernel_launch: unexpected problem (n_in %d out %d ws %zu need %zu)\n", n_in, out_size, ws_size, (size_t)WS_END); grid = -1; return; }
        int dev = 0, cus = 0, per_cu = 0;
        hipGetDevice(&dev); hipDeviceGetAttribute(&cus, hipDeviceAttributeMultiprocessorCount, dev);
        if (hipFuncSetAttribute((const void*)trunk_fwd, hipFuncAttributeMaxDynamicSharedMemorySize, LDS_BYTES) != hipSuccess) { fprintf(stderr, "hipFuncSetAttribute failed\n"); grid = -1; return; }
        if (hipOccupancyMaxActiveBlocksPerMultiprocessor(&per_cu, (const void*)trunk_fwd, NTHREADS, LDS_BYTES) != hipSuccess || per_cu < 1) { fprintf(stderr, "occupancy query failed (%d)\n", per_cu); per_cu = 1; }
        (void)hipGetLastError();
        grid = cus * 1;
        fprintf(stderr, "kernel_launch: cus %d per_cu %d grid %d ws %zu need %zu\n", cus, per_cu, grid, ws_size, (size_t)WS_END);
    }
    if (grid < 0) return;
    if (hipMemsetAsync((char*)d_ws + WS_CTL, 0, CTL_BYTES, stream) != hipSuccess) { fprintf(stderr, "memset failed\n"); return; }
    Args a{};
    for (int i = 0; i < 31; ++i) a.in[i] = d_in[i];
    a.out = (float*)d_out; a.ws = (unsigned char*)d_ws;
#ifdef MK_SPLIT
    for (int ph = 0; ph < NPH; ++ph) { a.ph_lo = ph; a.ph_hi = ph + 1; hipLaunchKernelGGL(trunk_fwd, dim3(grid), dim3(NTHREADS), LDS_BYTES, stream, a); }
#else
    a.ph_lo = 0; a.ph_hi = NPH;
    void* args[] = {&a};
    hipError_t e = hipLaunchCooperativeKernel((const void*)trunk_fwd, dim3(grid), dim3(NTHREADS), args, LDS_BYTES, stream);
    if (e != hipSuccess) fprintf(stderr, "cooperative launch failed: %s (grid %d)\n", hipGetErrorString(e), grid);
#endif
}
```

```cpp
#define REPSEL 0
#include <hip/hip_runtime.h>
#include <hip/hip_cooperative_groups.h>
#include <cstdio>
#include <cstdint>
namespace cg = cooperative_groups;
namespace pg8 {
#define PG8_LAS __attribute__((address_space(3)))
typedef unsigned short bf16_t;
typedef short bf16x8 __attribute__((ext_vector_type(8)));
typedef float f32x4 __attribute__((ext_vector_type(4)));
typedef unsigned u32x4 __attribute__((ext_vector_type(4)));
constexpr int BM = 256, BK = 64, HALF = 128, HTB = HALF * BK * 2  , STAGE_BYTES = 8 * HTB, NXCD = 8, WGM = 4;

__host__ __device__ __forceinline__ int lds_byte(int r, int c) { const int st = (r >> 4) * 2 + (c >> 5), rr = r & 15, cc = c & 31, ob = rr * 64 + cc * 2; return st * 1024 + (ob ^ (((ob >> 9) & 1) << 5)); }
__host__ __device__ __forceinline__ void stage_rc(int b, int& R, int& C) { const int st = b / 1024, sb = b % 1024, swz = sb ^ (((sb >> 9) & 1) << 5); R = (st >> 1) * 16 + swz / 64; C = (st & 1) * 32 + (swz % 64) / 2; }
__host__ __device__ __forceinline__ int perm32(int rho) { const int n = rho >> 4, i = rho & 15; return 8 * (i >> 2) + 4 * n + (i & 3); }

struct Unit { int pm, pn; };
struct Gemm { const bf16_t* A; const bf16_t* Bt; int M, N, K; };

struct StaticOrder {
    int nM, nN, nwg, G, c;
    __host__ __device__ void init(int M, int N, int G_, int c_) { nM = M / BM; nN = N / BM; nwg = nM * nN; G = G_; c = c_; }
    __host__ __device__ bool next(int i, Unit& u) const {
        const long L = (long)i * G + c; if (L >= nwg) return false;
        int wgid = (int)L; { const int q = nwg / NXCD, r = nwg % NXCD, xcd = wgid % NXCD, off = wgid / NXCD; wgid = (xcd < r ? xcd * (q + 1) : r * (q + 1) + (xcd - r) * q) + off; }
        const int nig = WGM * nN, gid = wgid / nig, fm = gid * WGM, gsz = (nM - fm) < WGM ? (nM - fm) : WGM;
        u.pm = fm + ((wgid % nig) % gsz); u.pn = (wgid % nig) / gsz; return true;
    }
    __device__ __forceinline__ void a_ready(const Unit&) const {}
    __device__ __forceinline__ void done(const Unit&) const {}
};

__device__ __forceinline__ unsigned cvt_pk_bf16(float lo, float hi) { unsigned r; asm volatile("v_cvt_pk_bf16_f32 %0, %1, %2" : "=v"(r) : "v"(lo), "v"(hi)); return r; }
typedef float f32x2e __attribute__((ext_vector_type(2))); typedef __bf16 bf16x2e __attribute__((ext_vector_type(2)));
__device__ __forceinline__ unsigned pk_bf16(float lo, float hi) { f32x2e v = {lo, hi}; bf16x2e b = __builtin_convertvector(v, bf16x2e); return __builtin_bit_cast(unsigned, b); }
__device__ __forceinline__ float group_rstd(const float* ssp, int rowbase, int fr, int fq) {
    const int lane = fq * 16 + fr;
    const f32x4* p = (const f32x4*)(ssp + (size_t)(rowbase + (lane >> 2)) * 32 + (lane & 3) * 8);
    const f32x4 a = p[0], b = p[1];
    float t = ((a.x + a.y) + (a.z + a.w)) + ((b.x + b.y) + (b.z + b.w));
    t += __shfl_xor(t, 1); t += __shfl_xor(t, 2);
    const float rs = rsqrtf(t * (1.0f / 2048.0f) + 1e-6f);
    return __shfl(rs, fr * 4);
}
__device__ __forceinline__ void tile_rstd(float (&rs)[2][4], const float* ssp, int rowtile, int wr, int fr, int fq) {
    const int lane = fq * 16 + fr; f32x4 pa[2][4][2];
#pragma unroll
    for (int ai = 0; ai < 2; ++ai)
#pragma unroll
        for (int m = 0; m < 4; ++m) { const f32x4* p = (const f32x4*)(ssp + (size_t)(rowtile + wr * 64 + ai * HALF + m * 16 + (lane >> 2)) * 32 + (lane & 3) * 8); pa[ai][m][0] = p[0]; pa[ai][m][1] = p[1]; }
#pragma unroll
    for (int ai = 0; ai < 2; ++ai)
#pragma unroll
        for (int m = 0; m < 4; ++m) { const f32x4 a = pa[ai][m][0], b = pa[ai][m][1];
            float t = ((a.x + a.y) + (a.z + a.w)) + ((b.x + b.y) + (b.z + b.w));
            t += __shfl_xor(t, 1); t += __shfl_xor(t, 2);
            rs[ai][m] = __shfl(rsqrtf(t * (1.0f / 2048.0f) + 1e-6f), fr * 4); }
}
struct EpiStore {
    static constexpr bool PERM = true, AFTER_DRAIN = false;
    bf16_t* O; int ldc; const float* ss;
    __device__ __forceinline__ void operator()(const f32x4 (&acc)[2][2][4][2], const Unit& u, int wr, int wc, int fr, int fq) const {
        const int row0 = u.pm * BM + wr * 64 + fr; const int col0 = u.pn * BM + wc * 32 + 8 * fq;
        float rsa[2][4];
#pragma unroll
        for (int ai = 0; ai < 2; ++ai)
#pragma unroll
            for (int m = 0; m < 4; ++m) rsa[ai][m] = 1.0f;
        if (ss) tile_rstd(rsa, ss, u.pm * BM, wr, fr, fq);
#pragma unroll
        for (int ai = 0; ai < 2; ++ai)
#pragma unroll
            for (int m = 0; m < 4; ++m) { bf16_t* rowp = O + (size_t)(row0 + ai * HALF + m * 16) * ldc + col0;
                const float rs = rsa[ai][m];
#pragma unroll
                for (int bj = 0; bj < 2; ++bj) { const f32x4 v0 = acc[ai][bj][m][0] * rs, v1 = acc[ai][bj][m][1] * rs;
                    u32x4 w; w.x = pk_bf16(v0[0], v0[1]); w.y = pk_bf16(v0[2], v0[3]); w.z = pk_bf16(v1[0], v1[1]); w.w = pk_bf16(v1[2], v1[3]);
                    *(u32x4*)(rowp + bj * HALF) = w; } }
    }
};
__device__ __forceinline__ float silu_mul(float g, float u) { return g * __builtin_amdgcn_rcpf(1.0f + __builtin_amdgcn_exp2f(-1.4426950408889634f * g)) * u; }
struct EpiSwiglu {
    static constexpr bool PERM = true, AFTER_DRAIN = false;
    bf16_t* O; int ldc; const float* ss;
    __device__ __forceinline__ void operator()(const f32x4 (&acc)[2][2][4][2], const Unit& u, int wr, int wc, int fr, int fq) const {
        const int row0 = u.pm * BM + wr * 64 + fr; const int col0 = u.pn * HALF + wc * 32 + 8 * fq;
        float rsa[2][4]; tile_rstd(rsa, ss, u.pm * BM, wr, fr, fq);
#pragma unroll
        for (int ai = 0; ai < 2; ++ai)
#pragma unroll
            for (int m = 0; m < 4; ++m) { bf16_t* rowp = O + (size_t)(row0 + ai * HALF + m * 16) * ldc + col0;
                const float rs = rsa[ai][m];
                const f32x4 g0 = acc[ai][0][m][0] * rs, g1 = acc[ai][0][m][1] * rs, u0 = acc[ai][1][m][0] * rs, u1 = acc[ai][1][m][1] * rs;
                u32x4 w; w.x = pk_bf16(silu_mul(g0[0], u0[0]), silu_mul(g0[1], u0[1])); w.y = pk_bf16(silu_mul(g0[2], u0[2]), silu_mul(g0[3], u0[3]));
                w.z = pk_bf16(silu_mul(g1[0], u1[0]), silu_mul(g1[1], u1[1])); w.w = pk_bf16(silu_mul(g1[2], u1[2]), silu_mul(g1[3], u1[3]));
                *(u32x4*)rowp = w; }
    }
};
struct EpiResid {
    static constexpr bool PERM = true, AFTER_DRAIN = false;
    bf16_t* H; int ldc; float* ss;
    __device__ __forceinline__ void operator()(const f32x4 (&acc)[2][2][4][2], const Unit& u, int wr, int wc, int fr, int fq) const {
        const int col0 = u.pn * BM + wc * 32 + 8 * fq;
        bf16_t* base = H + (size_t)(u.pm * BM + wr * 64 + fr) * ldc + col0;
        u32x4 r[2][4][2];
#pragma unroll
        for (int ai = 0; ai < 2; ++ai)
#pragma unroll
            for (int m = 0; m < 4; ++m)
#pragma unroll
                for (int bj = 0; bj < 2; ++bj) r[ai][m][bj] = *(const u32x4*)(base + (size_t)(ai * HALF + m * 16) * ldc + bj * HALF);
#pragma unroll
        for (int ai = 0; ai < 2; ++ai)
#pragma unroll
            for (int m = 0; m < 4; ++m) { const int row = u.pm * BM + ai * HALF + wr * 64 + m * 16 + fr; bf16_t* rowp = base + (size_t)(ai * HALF + m * 16) * ldc;
                float qs = 0.f;
#pragma unroll
                for (int bj = 0; bj < 2; ++bj) { const f32x4 a0 = acc[ai][bj][m][0], a1 = acc[ai][bj][m][1]; const u32x4 q = r[ai][m][bj]; u32x4 w;
                    w.x = pk_bf16(__uint_as_float(q.x << 16) + a0.x, __uint_as_float(q.x & 0xffff0000u) + a0.y);
                    w.y = pk_bf16(__uint_as_float(q.y << 16) + a0.z, __uint_as_float(q.y & 0xffff0000u) + a0.w);
                    w.z = pk_bf16(__uint_as_float(q.z << 16) + a1.x, __uint_as_float(q.z & 0xffff0000u) + a1.y);
                    w.w = pk_bf16(__uint_as_float(q.w << 16) + a1.z, __uint_as_float(q.w & 0xffff0000u) + a1.w);
                    *(u32x4*)(rowp + bj * HALF) = w;
#pragma unroll
                    for (int e = 0; e < 4; ++e) { const float h0 = __uint_as_float(w[e] << 16), h1 = __uint_as_float(w[e] & 0xffff0000u); qs += h0 * h0 + h1 * h1; } }
                qs += __shfl_xor(qs, 16); qs += __shfl_xor(qs, 32);
                if (fq == 0) ss[(size_t)row * 32 + u.pn * 4 + wc] = qs; }
    }
};
template <class Epi, class Sched, bool ALIGN_EPI = false, bool SP2 = false>
__device__ __forceinline__ void gemm_phase(PG8_LAS unsigned char* lds, const Gemm g, const Sched& S, const Epi& E) {
    int tid_l = threadIdx.x; asm volatile("" : "+v"(tid_l)); const int tid = tid_l, wid = __builtin_amdgcn_readfirstlane(tid >> 6), lane = tid & 63, wr = wid >> 2, wc = wid & 3, fr = lane & 15, fq = lane >> 4;
    const int K = g.K, nt = K / BK;
    unsigned voffA[2], voffB[2];
#pragma unroll
    for (int i = 0; i < 2; ++i) { int R, C; stage_rc(tid * 16 + i * 8192, R, C); const int Rb = Epi::PERM ? ((R & ~31) + perm32(R & 31)) : R;
        voffA[i] = (unsigned)(R * K + C) * 2u; voffB[i] = (unsigned)(Rb * K + C) * 2u; }
    const size_t kstep = (size_t)(BK * 2);
    const size_t hstep = (size_t)HALF * K * 2;
    const size_t tstep = 2 * hstep;
    const unsigned ldsw = (unsigned)wid * 1024u;
    const int aoff = lds_byte(wr * 64 + fr, fq * 8), boff = lds_byte(wc * 32 + fr, fq * 8);
#define PG8_SA(b, h) (((b) * 2 + (h)) * HTB)
#define PG8_SB(b, h) ((4 + (b) * 2 + (h)) * HTB)
#define PG8_STAGE(bufoff, gbase, voff) do { _Pragma("unroll") for (int _i = 0; _i < 2; ++_i) \
        __builtin_amdgcn_global_load_lds((const unsigned*)((const char*)(gbase) + (voff)[_i]), (PG8_LAS unsigned*)(lds + (bufoff) + ldsw + _i * 8192), 16, 0, 0); } while (0)
#define PG8_LDA(dst, b, h) do { _Pragma("unroll") for (int m = 0; m < 4; ++m) _Pragma("unroll") for (int k = 0; k < 2; ++k) dst[m][k] = *(const PG8_LAS bf16x8*)(lds + PG8_SA(b, h) + aoff + m * 2048 + k * 1024); } while (0)
#define PG8_LDB(dst, b, h) do { _Pragma("unroll") for (int n = 0; n < 2; ++n) _Pragma("unroll") for (int k = 0; k < 2; ++k) dst[n][k] = *(const PG8_LAS bf16x8*)(lds + PG8_SB(b, h) + boff + n * 2048 + k * 1024); } while (0)
#define PG8_MMA(ai, bj, At, Bt) do { __builtin_amdgcn_s_setprio(1); _Pragma("unroll") for (int m = 0; m < 4; ++m) _Pragma("unroll") for (int n = 0; n < 2; ++n) _Pragma("unroll") for (int k = 0; k < 2; ++k) \
        acc[ai][bj][m][n] = __builtin_amdgcn_mfma_f32_16x16x32_bf16(Bt[n][k], At[m][k], acc[ai][bj][m][n], 0, 0, 0); __builtin_amdgcn_s_setprio(0); } while (0)
#define PG8_WAIT_V(n) asm volatile("s_waitcnt vmcnt(" #n ")" ::: "memory")
#define PG8_WAIT_L(n) asm volatile("s_waitcnt lgkmcnt(" #n ")" ::: "memory")
#define PG8_BAR __builtin_amdgcn_s_barrier()
#define PG8_SCHED __builtin_amdgcn_sched_barrier(0)
    Unit cur, nxt; int ui = 0;
    if (!S.next(0, cur)) return;
    f32x4 acc[2][2][4][2];
#pragma unroll
    for (int a = 0; a < 2; ++a)
#pragma unroll
        for (int b = 0; b < 2; ++b)
#pragma unroll
            for (int m = 0; m < 4; ++m)
#pragma unroll
                for (int n = 0; n < 2; ++n) acc[a][b][m][n] = (f32x4){0.f, 0.f, 0.f, 0.f};
    bf16x8 At[4][2], B0[2][2], B1[2][2];
    const char* cA = (const char*)g.A + (size_t)cur.pm * tstep; const char* cB = (const char*)g.Bt + (size_t)cur.pn * tstep;
    S.a_ready(cur);
    if constexpr (SP2) {
        PG8_STAGE(PG8_SB(0, 0), cB, voffB); PG8_STAGE(PG8_SB(0, 1), cB + hstep, voffB); PG8_STAGE(PG8_SA(0, 0), cA, voffA); PG8_STAGE(PG8_SA(0, 1), cA + hstep, voffA);
        if (wr == 1) PG8_BAR;
        PG8_WAIT_V(2); PG8_BAR;
        PG8_STAGE(PG8_SB(1, 0), cB + kstep, voffB); PG8_STAGE(PG8_SA(1, 0), cA + kstep, voffA); PG8_STAGE(PG8_SB(1, 1), cB + hstep + kstep, voffB);
        PG8_WAIT_V(6); PG8_BAR;
    } else {
        PG8_STAGE(PG8_SB(0, 0), cB, voffB); PG8_STAGE(PG8_SA(0, 0), cA, voffA); PG8_STAGE(PG8_SB(0, 1), cB + hstep, voffB); PG8_STAGE(PG8_SA(0, 1), cA + hstep, voffA);
        if (wr == 1) PG8_BAR;
        PG8_WAIT_V(4); PG8_BAR;
        PG8_STAGE(PG8_SB(1, 0), cB + kstep, voffB); PG8_STAGE(PG8_SA(1, 0), cA + kstep, voffA); PG8_STAGE(PG8_SB(1, 1), cB + hstep + kstep, voffB);
        PG8_WAIT_V(6); PG8_BAR;
    }
    for (;;) {
        const bool has_next = S.next(ui + 1, nxt);
        const char* nA = has_next ? (const char*)g.A + (size_t)nxt.pm * tstep : cA; const char* nB = has_next ? (const char*)g.Bt + (size_t)nxt.pn * tstep : cB;
        for (int t = 0; t < nt; t += 2) {
            const bool last = (t == nt - 2);
            const char* a1 = cA + (size_t)(t + 1) * kstep;
            const char* a2 = last ? nA : cA + (size_t)(t + 2) * kstep; const char* b2 = last ? nB : cB + (size_t)(t + 2) * kstep;
            const char* a3 = a2 + kstep; const char* b3 = b2 + kstep;
            if (last && has_next) S.a_ready(nxt);
            if constexpr (SP2) {
            PG8_LDB(B0, 0, 0); PG8_LDB(B1, 0, 1); PG8_SCHED; PG8_LDA(At, 0, 0); PG8_STAGE(PG8_SA(1, 1), a1 + hstep, voffA);
            PG8_WAIT_V(8); PG8_WAIT_L(0); PG8_BAR; PG8_MMA(0, 0, At, B0); PG8_MMA(0, 1, At, B1); PG8_BAR; PG8_SCHED;
            PG8_LDA(At, 0, 1); PG8_STAGE(PG8_SB(0, 0), b2, voffB); PG8_STAGE(PG8_SB(0, 1), b2 + hstep, voffB); PG8_STAGE(PG8_SA(0, 0), a2, voffA);
            PG8_WAIT_V(8); PG8_WAIT_L(0); PG8_BAR; PG8_MMA(1, 0, At, B0); PG8_MMA(1, 1, At, B1); PG8_BAR; PG8_SCHED;
            PG8_LDB(B0, 1, 0); PG8_LDB(B1, 1, 1); PG8_SCHED; PG8_LDA(At, 1, 0); PG8_STAGE(PG8_SA(0, 1), a2 + hstep, voffA);
            PG8_WAIT_V(8); PG8_WAIT_L(0); PG8_BAR; PG8_MMA(0, 0, At, B0); PG8_MMA(0, 1, At, B1); PG8_BAR; PG8_SCHED;
            PG8_LDA(At, 1, 1); PG8_STAGE(PG8_SB(1, 0), b3, voffB); PG8_STAGE(PG8_SB(1, 1), b3 + hstep, voffB); PG8_STAGE(PG8_SA(1, 0), a3, voffA);
            PG8_WAIT_V(8); PG8_WAIT_L(0); PG8_BAR; PG8_MMA(1, 0, At, B0); PG8_MMA(1, 1, At, B1); PG8_BAR; PG8_SCHED;
            } else {
            PG8_LDB(B0, 0, 0); PG8_SCHED; PG8_LDA(At, 0, 0); PG8_STAGE(PG8_SA(1, 1), a1 + hstep, voffA);
            PG8_WAIT_L(8); PG8_BAR; PG8_WAIT_L(0); PG8_MMA(0, 0, At, B0); PG8_BAR; PG8_SCHED;
            PG8_LDB(B1, 0, 1); PG8_STAGE(PG8_SB(0, 0), b2, voffB);
            PG8_BAR; PG8_WAIT_L(0); PG8_MMA(0, 1, At, B1); PG8_BAR;
            PG8_LDA(At, 0, 1); PG8_STAGE(PG8_SA(0, 0), a2, voffA);
            PG8_BAR; PG8_WAIT_L(0); PG8_MMA(1, 0, At, B0); PG8_BAR; PG8_SCHED;
            PG8_STAGE(PG8_SB(0, 1), b2 + hstep, voffB);
            PG8_WAIT_V(6); PG8_BAR; PG8_MMA(1, 1, At, B1); PG8_BAR;
            PG8_LDB(B0, 1, 0); PG8_SCHED; PG8_LDA(At, 1, 0); PG8_STAGE(PG8_SA(0, 1), a2 + hstep, voffA);
            PG8_WAIT_L(8); PG8_BAR; PG8_WAIT_L(0); PG8_MMA(0, 0, At, B0); PG8_BAR; PG8_SCHED;
            PG8_LDB(B1, 1, 1); PG8_STAGE(PG8_SB(1, 0), b3, voffB);
            PG8_BAR; PG8_WAIT_L(0); PG8_MMA(0, 1, At, B1); PG8_BAR;
            PG8_LDA(At, 1, 1); PG8_STAGE(PG8_SA(1, 0), a3, voffA);
            PG8_BAR; PG8_WAIT_L(0); PG8_MMA(1, 0, At, B0); PG8_BAR; PG8_SCHED;
            PG8_STAGE(PG8_SB(1, 1), b3 + hstep, voffB);
            PG8_WAIT_V(6); PG8_BAR; PG8_MMA(1, 1, At, B1); PG8_BAR;
            }
        }
        if constexpr (ALIGN_EPI) { if (wr == 0) PG8_BAR; }
        if constexpr (!Epi::AFTER_DRAIN) { E(acc, cur, wr, wc, fr, fq); S.done(cur); }
        if (!has_next) break;
#pragma unroll
        for (int a = 0; a < 2; ++a)
#pragma unroll
            for (int b = 0; b < 2; ++b)
#pragma unroll
                for (int m = 0; m < 4; ++m)
#pragma unroll
                    for (int n = 0; n < 2; ++n) acc[a][b][m][n] = (f32x4){0.f, 0.f, 0.f, 0.f};
        cur = nxt; cA = nA; cB = nB; ++ui;
        if constexpr (ALIGN_EPI) { if (wr == 1) PG8_BAR; }
    }
    PG8_WAIT_V(0);
    if constexpr (!ALIGN_EPI) { if (wr == 0) PG8_BAR; }
    PG8_BAR;
    if constexpr (Epi::AFTER_DRAIN) { E.fused(acc, cur, wr, wc, fr, fq, lds, wid, lane); S.done(cur); }
#undef PG8_SA
#undef PG8_SB
#undef PG8_STAGE
#undef PG8_LDA
#undef PG8_LDB
#undef PG8_MMA
#undef PG8_WAIT_V
#undef PG8_WAIT_L
#undef PG8_BAR
#undef PG8_SCHED
}
}
#define LAS __attribute__((address_space(3)))
typedef unsigned short bf16;
typedef unsigned u32x4 __attribute__((ext_vector_type(4)));
typedef unsigned u32x2 __attribute__((ext_vector_type(2)));
typedef float f32x4 __attribute__((ext_vector_type(4)));
typedef float f32x16 __attribute__((ext_vector_type(16)));
typedef short bf16x8 __attribute__((ext_vector_type(8)));
typedef short s16x4 __attribute__((ext_vector_type(4)));

constexpr int T = 16384, SEQ = 4096, D = 2048, DEPTH = 4;
constexpr int EV_IN = 6432, EV_IN_P = 6656, OD_IN = 1600, OD_IN_P = 1792, DFF = 5632;
constexpr int LORA_K = 384, LORA_N = 3072, RWKV_IN = 3360;
constexpr float NORM_EPS = 1e-6f, GN_EPS = 64e-5f;
constexpr int NWAVES = 8, NTHREADS = 512;
constexpr int LDS_BYTES = 147456;

constexpr size_t al(size_t x) { return (x + 255) & ~(size_t)255; }
constexpr size_t SZ_EVIN = (size_t)EV_IN_P * D * 2, SZ_EVLORA = (size_t)LORA_N * LORA_K * 2, SZ_WOUT = (size_t)D * D * 2, SZ_ODIN = (size_t)OD_IN_P * D * 2,
                 SZ_POOL = 512 * 512 * 2, SZ_UQ = 2304 * 512 * 2, SZ_UKV = 3072 * 512 * 2;
constexpr size_t WS_EVIN = 0, WS_EVLORA = WS_EVIN + 2 * SZ_EVIN, WS_EVOUT = WS_EVLORA + 2 * SZ_EVLORA, WS_ODIN = WS_EVOUT + 2 * SZ_WOUT,
                 WS_POOL = WS_ODIN + 2 * SZ_ODIN, WS_UQ = WS_POOL + 2 * SZ_POOL, WS_UKV = WS_UQ + 2 * SZ_UQ, WS_ODOUT = WS_UKV + 2 * SZ_UKV,
                 WS_FGU = WS_ODOUT + 2 * SZ_WOUT, WS_FD = WS_FGU + (size_t)2 * DFF * D * 2, SZ_FFN = (size_t)3 * DFF * D * 2, WS_ROPE = WS_FGU + 2 * SZ_FFN,
                 WS_XN = WS_ROPE + (size_t)T * 32 * 8, WS_P = WS_XN + (size_t)T * D * 2, WS_LO = WS_P + (size_t)T * EV_IN_P * 2,
                 WS_AL = WS_LO + (size_t)T * LORA_N * 2, WS_SI = WS_AL + (size_t)T * LORA_K * 2, WS_SW = WS_SI + (size_t)T * 1024 * 8,
                 WS_SV = WS_SW + (size_t)T * 1024 * 4, WS_CTL = WS_SV + (size_t)T * 1024 * 2, CTL_BYTES = 65536, WS_SS = WS_CTL + CTL_BYTES, WS_END = WS_SS + 2 * (size_t)T * 32 * 4;
static_assert((size_t)16384 * 10496 <= (size_t)T * 1024 * 8 + (40u << 20) && (41u << 20) <= (size_t)T * 1024 * 4, "OPS + COEF fit SI|SW");
static_assert(WS_EVLORA % 256 == 0 && WS_ROPE % 256 == 0 && WS_XN % 256 == 0 && WS_SV % 256 == 0, "alignment");

__device__ __forceinline__ float bflo(unsigned w) { return __uint_as_float(w << 16); }
__device__ __forceinline__ float bfhi(unsigned w) { return __uint_as_float(w & 0xffff0000u); }
__device__ __forceinline__ float bf2f(bf16 b) { return __uint_as_float((unsigned)b << 16); }
using pg8::pk_bf16;
__device__ __forceinline__ bf16 f2bf(float f) { return (bf16)(pk_bf16(f, 0.f) & 0xffffu); }
__device__ __forceinline__ void unpack8(const u32x4 w, float (&f)[8]) { f[0] = bflo(w.x); f[1] = bfhi(w.x); f[2] = bflo(w.y); f[3] = bfhi(w.y); f[4] = bflo(w.z); f[5] = bfhi(w.z); f[6] = bflo(w.w); f[7] = bfhi(w.w); }
__device__ __forceinline__ u32x4 pack8(const float (&f)[8]) { u32x4 w; w.x = pk_bf16(f[0], f[1]); w.y = pk_bf16(f[2], f[3]); w.z = pk_bf16(f[4], f[5]); w.w = pk_bf16(f[6], f[7]); return w; }
__device__ __forceinline__ float wave_sum(float v) {
#pragma unroll
    for (int o = 1; o < 64; o <<= 1) v += __shfl_xor(v, o);
    return v;
}
__device__ __forceinline__ float fexp(float x) { return __builtin_amdgcn_exp2f(x * 1.4426950408889634f); }
__device__ __forceinline__ float flog(float x) { return __builtin_amdgcn_logf(x) * 0.6931471805599453f; }
__device__ __forceinline__ float fsigmoid(float x) { return __builtin_amdgcn_rcpf(1.0f + fexp(-x)); }
__device__ __forceinline__ float ftanh(float x) { return 1.0f - 2.0f * __builtin_amdgcn_rcpf(1.0f + fexp(2.0f * x)); }

__device__ __forceinline__ void tr_item(const float* W, int Ksrc, int N, int k0, int n0, bf16* dst, int ldt, int drow0, int dcol0, LAS float* scr, int lane, const float* nscale = nullptr, const float* kscale = nullptr) {
    f32x4 tv[8]; const int kr_ = lane >> 3, nq_ = lane & 7;
#pragma unroll
    for (int i = 0; i < 8; ++i) { const int kk = 8 * i + kr_; const int kr = (k0 + kk < Ksrc) ? (k0 + kk) : (Ksrc - 1); tv[i] = __builtin_nontemporal_load((const f32x4*)(W + (size_t)kr * N + n0 + 4 * nq_)); }
#pragma unroll
    for (int i = 0; i < 8; ++i) { const int kk = 8 * i + kr_; const bool ok = (k0 + kk < Ksrc); LAS float* d_ = scr + kk * 33 + 4 * nq_;
        const float ks_ = (ok && kscale) ? kscale[k0 + kk] : 1.0f;
        d_[0] = ok ? tv[i].x * ks_ : 0.f; d_[1] = ok ? tv[i].y * ks_ : 0.f; d_[2] = ok ? tv[i].z * ks_ : 0.f; d_[3] = ok ? tv[i].w * ks_ : 0.f; }
    asm volatile("s_waitcnt lgkmcnt(0)" ::: "memory");
    const int c = lane & 7;
#pragma unroll
    for (int j = 0; j < 4; ++j) { const int n = (lane >> 3) + 8 * j; const LAS float* s = scr + (8 * c) * 33 + n;
        const float sc = nscale ? nscale[n0 + n] : 1.0f;
        u32x4 o; o.x = pk_bf16(s[0 * 33] * sc, s[1 * 33] * sc); o.y = pk_bf16(s[2 * 33] * sc, s[3 * 33] * sc); o.z = pk_bf16(s[4 * 33] * sc, s[5 * 33] * sc); o.w = pk_bf16(s[6 * 33] * sc, s[7 * 33] * sc);
        *(u32x4*)(dst + (size_t)(drow0 + n) * ldt + dcol0 + k0 + 8 * c) = o; }
    asm volatile("s_waitcnt lgkmcnt(0)" ::: "memory");
}
__device__ __forceinline__ void tr_matrix(const float* W, int Ksrc, int N, bf16* dst, int ldt, int dcol0, int rowmode, int drow_off, LAS float* scr, int gw, int ngw, int lane, const float* nscale = nullptr, const float* kscale = nullptr) {
    const int nkb = (Ksrc + 63) / 64, nnb = N / 32, items = nkb * nnb;
    for (int it = gw; it < items; it += ngw) { const int kb = it / nnb, nb = it - kb * nnb, n0 = nb * 32;
        const int drow0 = rowmode ? ((n0 >> 7) * 256 + (n0 & 127) + drow_off) : (drow_off + n0);
        tr_item(W, Ksrc, N, kb * 64, n0, dst, ldt, drow0, dcol0, scr, lane, nscale, kscale); }
}
__device__ __forceinline__ void zero_fill(void* p, size_t bytes, int gtid, int gthreads) {
    u32x4* q = (u32x4*)p; const size_t n = bytes / 16;
    for (size_t i = gtid; i < n; i += gthreads) q[i] = (u32x4){0u, 0u, 0u, 0u};
}
__device__ __forceinline__ void ld8f(const float* p, float (&f)[8]) { const f32x4 a = *(const f32x4*)p, b = *(const f32x4*)(p + 4); f[0] = a.x; f[1] = a.y; f[2] = a.z; f[3] = a.w; f[4] = b.x; f[5] = b.y; f[6] = b.z; f[7] = b.w; }
__device__ __forceinline__ void zero_lora_pool(bf16* lora_t, bf16* pool_t, int gtid, int gthreads) {
    for (int e = gtid; e < 3072 * 48; e += gthreads) { const int n = e / 48, c = e - n * 48, seg = n >> 10; const int lo = seg == 0 ? 0 : (seg == 1 ? 8 : 16), hi = seg == 0 ? 8 : (seg == 1 ? 16 : 40);
        if (c < lo || c >= hi) *(u32x4*)(lora_t + (size_t)n * 384 + c * 8) = (u32x4){0u, 0u, 0u, 0u}; }
    for (int e = gtid; e < 512 * 64; e += gthreads) { const int r = e >> 6, c = e & 63;
        if ((c >> 4) != (r >> 7)) *(u32x4*)(pool_t + (size_t)r * 512 + c * 8) = (u32x4){0u, 0u, 0u, 0u}; }
}
__device__ __forceinline__ void norm_rows(const float* x32, bf16* h16, bf16* xn, float* fout, const float* g, int gw, int ngw, int lane) {
    for (int m0 = gw; m0 < T; m0 += 2 * ngw) {
        float v[2][4][8];
#pragma unroll
        for (int r = 0; r < 2; ++r) { const int m = m0 + r * ngw;
            if (x32) {
#pragma unroll
                for (int j = 0; j < 4; ++j) { const f32x4 a = *(const f32x4*)(x32 + (size_t)m * D + (64 * j + lane) * 8), b = *(const f32x4*)(x32 + (size_t)m * D + (64 * j + lane) * 8 + 4);
                    v[r][j][0] = a.x; v[r][j][1] = a.y; v[r][j][2] = a.z; v[r][j][3] = a.w; v[r][j][4] = b.x; v[r][j][5] = b.y; v[r][j][6] = b.z; v[r][j][7] = b.w; }
            } else {
#pragma unroll
                for (int j = 0; j < 4; ++j) unpack8(*(const u32x4*)(h16 + (size_t)m * D + (64 * j + lane) * 8), v[r][j]);
            } }
#pragma unroll
        for (int r = 0; r < 2; ++r) { const int m = m0 + r * ngw; float s = 0.f;
            if (x32) {
#pragma unroll
                for (int j = 0; j < 4; ++j) { const u32x4 w = pack8(v[r][j]); *(u32x4*)(h16 + (size_t)m * D + (64 * j + lane) * 8) = w; unpack8(w, v[r][j]); } }
#pragma unroll
            for (int j = 0; j < 4; ++j)
#pragma unroll
                for (int e = 0; e < 8; ++e) s += v[r][j][e] * v[r][j][e];
            s = wave_sum(s);
            const float sc = rsqrtf(s * (1.0f / D) + NORM_EPS);
#pragma unroll
            for (int j = 0; j < 4; ++j) { float gg[8], o[8]; ld8f(g + (64 * j + lane) * 8, gg);
#pragma unroll
                for (int e = 0; e < 8; ++e) o[e] = v[r][j][e] * sc * gg[e];
                if (xn) *(u32x4*)(xn + (size_t)m * D + (64 * j + lane) * 8) = pack8(o);
                if (fout) { float* fp = fout + (size_t)m * D + (64 * j + lane) * 8; *(f32x4*)fp = (f32x4){o[0], o[1], o[2], o[3]}; *(f32x4*)(fp + 4) = (f32x4){o[4], o[5], o[6], o[7]}; } } }
    }
}
__device__ __forceinline__ void init_rows(const float* x32, bf16* h16, float* ssp, int gw, int ngw, int lane) {
    for (int m = gw; m < T; m += ngw) { float s = 0.f;
#pragma unroll
        for (int j = 0; j < 4; ++j) { float v[8]; ld8f(x32 + (size_t)m * D + (64 * j + lane) * 8, v); const u32x4 w = pack8(v); *(u32x4*)(h16 + (size_t)m * D + (64 * j + lane) * 8) = w; unpack8(w, v);
#pragma unroll
            for (int e = 0; e < 8; ++e) s += v[e] * v[e]; }
        s = wave_sum(s);
        if (lane < 32) ssp[(size_t)m * 32 + lane] = (lane == 0) ? s : 0.f; }
}
__device__ __forceinline__ void final_rows(const bf16* h16, const float* ssp, const float* g, float* out, int gw, int ngw, int lane) {
    for (int m = gw; m < T; m += ngw) { float t = 0.f;
#pragma unroll
        for (int i = 0; i < 8; ++i) { const f32x4 q = *(const f32x4*)(ssp + (size_t)m * 32 + 4 * i); t += (q.x + q.y) + (q.z + q.w); }
        const float sc = rsqrtf(t * (1.0f / D) + NORM_EPS);
#pragma unroll
        for (int j = 0; j < 4; ++j) { float v[8], gg[8]; unpack8(*(const u32x4*)(h16 + (size_t)m * D + (64 * j + lane) * 8), v); ld8f(g + (64 * j + lane) * 8, gg);
            float* fp = out + (size_t)m * D + (64 * j + lane) * 8;
            *(f32x4*)fp = (f32x4){v[0] * sc * gg[0], v[1] * sc * gg[1], v[2] * sc * gg[2], v[3] * sc * gg[3]}; *(f32x4*)(fp + 4) = (f32x4){v[4] * sc * gg[4], v[5] * sc * gg[5], v[6] * sc * gg[6], v[7] * sc * gg[7]}; } }
}
__device__ __forceinline__ void rope_table(const int* pos, float* rope, int gtid, int gthreads) {
    for (int e = gtid; e < T * 32; e += gthreads) { const int m = e >> 5, i = e & 31;
        const float inv = exp2f(-(float)i * (13.287712379549449f / 32.0f));
        const float ang = (float)pos[m] * inv;
        const double rev = (double)ang * 0.15915494309189535; const double fr = rev - rint(rev);
        const float a = (float)(fr * 6.283185307179586);
        rope[2 * e] = __cosf(a); rope[2 * e + 1] = __sinf(a); }
}

__device__ __forceinline__ void e2_phase(const bf16* P, const float* convw, const float* mu, bf16* mix, bf16* alora, int gw, int ngw, int lane) {
    for (int m = gw; m < T; m += ngw) { const int t = m & (SEQ - 1); const bf16* pr = P + (size_t)m * EV_IN_P;
#pragma unroll
        for (int i = 0; i < 2; ++i) { const int c = (lane + 64 * i) * 8;
            float bg[8], u0[8], u1[8], u2[8], tmp[8];
            unpack8(*(const u32x4*)(pr + c), bg);
            unpack8(*(const u32x4*)(pr + 1024 + c), u0); unpack8(*(const u32x4*)(pr + 2048 + c), tmp);
#pragma unroll
            for (int e = 0; e < 8; ++e) u0[e] *= tmp[e];
            if (t >= 1) { unpack8(*(const u32x4*)(pr - EV_IN_P + 1024 + c), u1); unpack8(*(const u32x4*)(pr - EV_IN_P + 2048 + c), tmp);
#pragma unroll
                for (int e = 0; e < 8; ++e) u1[e] *= tmp[e]; }
            else {
#pragma unroll
                for (int e = 0; e < 8; ++e) u1[e] = 0.f; }
            if (t >= 2) { unpack8(*(const u32x4*)(pr - 2 * EV_IN_P + 1024 + c), u2); unpack8(*(const u32x4*)(pr - 2 * EV_IN_P + 2048 + c), tmp);
#pragma unroll
                for (int e = 0; e < 8; ++e) u2[e] *= tmp[e]; }
            else {
#pragma unroll
                for (int e = 0; e < 8; ++e) u2[e] = 0.f; }
            float o[8]; const float* cw = convw + c * 3;
#pragma unroll
            for (int e = 0; e < 8; ++e) o[e] = bg[e] * (cw[3 * e + 2] * u0[e] + cw[3 * e + 1] * u1[e] + cw[3 * e] * u2[e]);
            *(u32x4*)(mix + (size_t)m * D + c) = pack8(o); }
#pragma unroll
        for (int i = 0; i < 6; ++i) { const int idx = lane + 64 * i; float val = 0.f;
            if (idx < 288) { const float pt = bf2f(pr[6144 + idx]); const float pp = (t >= 1) ? bf2f(pr[6144 + idx - EV_IN_P]) : 0.f;
                const float xs = pt + (pp - pt) * mu[3072 + idx];
                val = idx < 64 ? ftanh(xs) : (idx < 128 ? xs : fsigmoid(xs)); }
            alora[(size_t)m * LORA_K + idx] = f2bf(val); }
    }
}
__device__ __forceinline__ float sum8(float x) { x += __shfl_xor(x, 1); x += __shfl_xor(x, 2); x += __shfl_xor(x, 4); return x; }
__device__ __forceinline__ void e4_phase(const bf16* P, const bf16* LO, const float* mu, const float* w0, const float* a0, const float* k_k, const float* k_a,
                                         bf16* SI, float* SW, bf16* SV, int gw, int ngw, int lane) {
    const int hf = gw & 1, c = hf * 512 + lane * 8, h = c >> 6, cl = (lane & 7) * 8;
    float mu_r[8], mu_k[8], mu_v[8], w0c[8], a0c[8], kkc[8], kac[8];
    ld8f(mu + c, mu_r); ld8f(mu + 1024 + c, mu_k); ld8f(mu + 2048 + c, mu_v); ld8f(w0 + c, w0c); ld8f(a0 + c, a0c); ld8f(k_k + c, kkc); ld8f(k_a + c, kac);
    for (int m = gw >> 1; m < T; m += ngw >> 1) { const int t = m & (SEQ - 1), b = m >> 12; const bf16* pr = P + (size_t)m * EV_IN_P + 3072 + c;
        float r[8], k[8], v[8], r1[8], k1[8], v1[8], lw[8], la[8];
        unpack8(*(const u32x4*)pr, r); unpack8(*(const u32x4*)(pr + 1024), k); unpack8(*(const u32x4*)(pr + 2048), v);
        unpack8(*(const u32x4*)(LO + (size_t)m * LORA_N + c), lw); unpack8(*(const u32x4*)(LO + (size_t)m * LORA_N + 1024 + c), la);
        { const bf16* pp = (t >= 1) ? (pr - EV_IN_P) : pr; const float z1 = (t >= 1) ? 1.0f : 0.0f;
          unpack8(*(const u32x4*)pp, r1); unpack8(*(const u32x4*)(pp + 1024), k1); unpack8(*(const u32x4*)(pp + 2048), v1);
#pragma unroll
          for (int e = 0; e < 8; ++e) { r1[e] *= z1; k1[e] *= z1; v1[e] *= z1; } }
        float kk[8], kp[8], bb[8], dec[8]; float n2 = 0.f;
#pragma unroll
        for (int e = 0; e < 8; ++e) { r[e] += (r1[e] - r[e]) * mu_r[e]; k[e] += (k1[e] - k[e]) * mu_k[e]; v[e] += (v1[e] - v[e]) * mu_v[e];
            const float z = -(w0c[e] + lw[e]); const float sp = fmaxf(z, 0.f) + flog(1.0f + fexp(-fabsf(z))); const float w = -sp - 0.5f;
            dec[e] = fexp(-fexp(w));
            const float a = fsigmoid(a0c[e] + la[e]);
            kk[e] = k[e] * kkc[e]; n2 += kk[e] * kk[e];
            kp[e] = k[e] * (1.0f + (a - 1.0f) * kac[e]); bb[e] = a; }
        n2 = sum8(n2); const float inn = 1.0f / fmaxf(sqrtf(n2), 1e-12f);
#pragma unroll
        for (int e = 0; e < 8; ++e) { kk[e] *= inn; bb[e] *= kk[e]; }
        const size_t idx = (size_t)(b * 16 + h) * SEQ + t;
        bf16* si = SI + idx * 256 + cl;
        *(u32x4*)si = pack8(kp); *(u32x4*)(si + 64) = pack8(kk); *(u32x4*)(si + 128) = pack8(bb); *(u32x4*)(si + 192) = pack8(r);
        *(f32x4*)(SW + idx * 64 + cl) = (f32x4){dec[0], dec[1], dec[2], dec[3]}; *(f32x4*)(SW + idx * 64 + cl + 4) = (f32x4){dec[4], dec[5], dec[6], dec[7]};
        *(u32x4*)(SV + idx * 64 + cl) = pack8(v);
    }
}
__device__ __forceinline__ void e6_phase(const bf16* LO, const float* COEF, const bf16* SV, const float* ln_w, const float* ln_b, bf16* mix, int gw, int ngw, int lane) {
    const int hf = gw & 1, c = hf * 512 + lane * 8, h = c >> 6, cl = (lane & 7) * 8;
    float lw[8], lb[8]; ld8f(ln_w + c, lw); ld8f(ln_b + c, lb);
    for (int m = gw >> 1; m < T; m += ngw >> 1) { const int t = m & (SEQ - 1), b = m >> 12;
        bf16* yp = mix + (size_t)m * D + 1024 + c;
        const size_t idx = (size_t)(b * 16 + h) * SEQ + t;
        float y[8], v[8], g[8];
        unpack8(*(const u32x4*)yp, y); unpack8(*(const u32x4*)(SV + idx * 64 + cl), v); unpack8(*(const u32x4*)(LO + (size_t)m * LORA_N + 2048 + c), g);
        const float bs = COEF[(size_t)m * 16 + h];
        float s = 0.f;
#pragma unroll
        for (int e = 0; e < 8; ++e) s += y[e];
        s = sum8(s);
        const float mean = s * (1.0f / 64.0f); float q = 0.f;
#pragma unroll
        for (int e = 0; e < 8; ++e) { y[e] -= mean; q += y[e] * y[e]; }
        q = sum8(q); const float rs = rsqrtf(q * (1.0f / 64.0f) + GN_EPS);
        float o[8];
#pragma unroll
        for (int e = 0; e < 8; ++e) o[e] = (y[e] * rs * lw[e] + lb[e] + bs * v[e]) * g[e];
        *(u32x4*)yp = pack8(o);
    }
}
__device__ __forceinline__ float mul_s(float a, float b) { float r; asm("v_mul_f32_e32 %0, %1, %2" : "=v"(r) : "v"(a), "v"(b)); return r; }
__device__ __forceinline__ float add_s(float a, float b) { float r; asm("v_add_f32_e32 %0, %1, %2" : "=v"(r) : "v"(a), "v"(b)); return r; }
__device__ __forceinline__ float fma_s(float a, float b, float c) { float r; asm("v_fma_f32 %0, %1, %2, %3" : "=v"(r) : "v"(a), "v"(b), "v"(c)); return r; }
__device__ __forceinline__ float fnma_s(float a, float b, float c) { float r; asm("v_fma_f32 %0, -%1, %2, %3" : "=v"(r) : "v"(a), "v"(b), "v"(c)); return r; }
template <int CTRL> __device__ __forceinline__ float dppf(float x) { return __builtin_bit_cast(float, __builtin_amdgcn_update_dpp(0, __builtin_bit_cast(int, x), CTRL, 0xF, 0xF, true)); }
__device__ __forceinline__ float red16(float x) { x += dppf<0xB1>(x); x += dppf<0x4E>(x); x += dppf<0x124>(x); x += dppf<0x128>(x); return x; }
constexpr int SC_CH = 32, SC_STEPF = 336, SC_BUFF = SC_CH * SC_STEPF;
__device__ __forceinline__ void scan_issue(u32x4 (&rsi)[4], f32x4 (&rsw)[2], u32x4& rsv, const bf16* SI, const float* SW, const bf16* SV, size_t ib, int q4, int c, int lt) {
    const size_t t0 = ib + (size_t)c * SC_CH;
#pragma unroll
    for (int i = 0; i < 4; ++i) rsi[i] = *(const u32x4*)(SI + t0 * 256 + (size_t)(lt + 256 * i) * 8);
#pragma unroll
    for (int i = 0; i < 2; ++i) rsw[i] = *(const f32x4*)(SW + t0 * 64 + (size_t)(lt + 256 * i) * 4);
    if (lt < 64) rsv = *(const u32x4*)(SV + (t0 + (lt >> 1)) * 64 + q4 * 16 + (lt & 1) * 8);
}
__device__ __forceinline__ void scan_commit(const u32x4 (&rsi)[4], const f32x4 (&rsw)[2], const u32x4& rsv, LAS float* buf, int lt) {
#pragma unroll
    for (int i = 0; i < 4; ++i) { const int idx = lt + 256 * i, step = idx >> 5, within = idx & 31, vec = within >> 3, e = (within & 7) * 8;
        LAS float* d = buf + step * SC_STEPF + (1 + vec) * 64 + e; float f[8]; unpack8(rsi[i], f);
        *(LAS f32x4*)d = (f32x4){f[0], f[1], f[2], f[3]}; *(LAS f32x4*)(d + 4) = (f32x4){f[4], f[5], f[6], f[7]}; }
#pragma unroll
    for (int i = 0; i < 2; ++i) { const int idx = lt + 256 * i, step = idx >> 4, e = (idx & 15) * 4; *(LAS f32x4*)(buf + step * SC_STEPF + e) = rsw[i]; }
    if (lt < 64) { LAS float* d = buf + (lt >> 1) * SC_STEPF + 320 + (lt & 1) * 8; float f[8]; unpack8(rsv, f);
        *(LAS f32x4*)d = (f32x4){f[0], f[1], f[2], f[3]}; *(LAS f32x4*)(d + 4) = (f32x4){f[4], f[5], f[6], f[7]}; }
}
__device__ __forceinline__ void scan_yout(const LAS float* yb, bf16* mix, int mrow, int colbase, int lt) {
    const int step = lt >> 3, pr = lt & 7;
    const unsigned w = pk_bf16(yb[step * 16 + 2 * pr], yb[step * 16 + 2 * pr + 1]);
    *(unsigned*)(mix + (size_t)(mrow + step) * D + colbase + 2 * pr) = w;
}
__device__ __forceinline__ void scan_phase(LAS unsigned char* lds, const bf16* SI, const float* SW, const bf16* SV, bf16* mix, int bid, int G, int tid) {
    LAS float* buf = (LAS float*)lds; LAS float* ybuf = (LAS float*)(lds + 2 * SC_BUFF * 4);
    const int wid = __builtin_amdgcn_readfirstlane(tid >> 6), lane = tid & 63, lt = tid - 256;
    const bool loader = wid >= 4;
    for (int unit = bid; unit < 256; unit += G) {
        const int bh = unit >> 2, q4 = unit & 3, b = bh >> 4, h = bh & 15;
        const size_t ib = (size_t)bh * SEQ; const int mrow0 = b * SEQ, colbase = 1024 + h * 64 + q4 * 16;
        u32x4 rsi[4]; f32x4 rsw[2]; u32x4 rsv = (u32x4){0u, 0u, 0u, 0u};
        float s0 = 0.f, s1 = 0.f, s2 = 0.f, s3 = 0.f;
        const int rr = lane >> 4, kq = lane & 15, rowl = (wid & 3) * 4 + rr;
        if (loader) { scan_issue(rsi, rsw, rsv, SI, SW, SV, ib, q4, 0, lt); scan_commit(rsi, rsw, rsv, buf, lt); scan_issue(rsi, rsw, rsv, SI, SW, SV, ib, q4, 1, lt); }
        __syncthreads();
        for (int c = 0; c < SEQ / SC_CH; ++c) {
            if (!loader) {
                const LAS float* bb = buf + (c & 1) * SC_BUFF + 4 * kq; LAS float* yb = ybuf + (c & 1) * (SC_CH * 16);
                f32x4 w4 = *(const LAS f32x4*)bb, k4 = *(const LAS f32x4*)(bb + 64), kk4 = *(const LAS f32x4*)(bb + 128), b4 = *(const LAS f32x4*)(bb + 192), r4 = *(const LAS f32x4*)(bb + 256);
                float vv = bb[320 - 4 * kq + rowl];
#pragma unroll 8
                for (int s = 0; s < SC_CH; ++s) { const LAS float* p = bb + (s + 1 < SC_CH ? s + 1 : s) * SC_STEPF;
                    const f32x4 nw = *(const LAS f32x4*)p, nk = *(const LAS f32x4*)(p + 64), nkk = *(const LAS f32x4*)(p + 128), nb = *(const LAS f32x4*)(p + 192), nr = *(const LAS f32x4*)(p + 256);
                    const float nv = p[320 - 4 * kq + rowl];
                    float d = add_s(fma_s(s1, kk4.y, mul_s(s0, kk4.x)), fma_s(s3, kk4.w, mul_s(s2, kk4.z)));
                    const float t0 = fma_s(s0, w4.x, mul_s(vv, k4.x)), t1 = fma_s(s1, w4.y, mul_s(vv, k4.y)), t2 = fma_s(s2, w4.z, mul_s(vv, k4.z)), t3 = fma_s(s3, w4.w, mul_s(vv, k4.w));
                    d = red16(d);
                    s0 = fnma_s(d, b4.x, t0); s1 = fnma_s(d, b4.y, t1); s2 = fnma_s(d, b4.z, t2); s3 = fnma_s(d, b4.w, t3);
                    float y = add_s(fma_s(s1, r4.y, mul_s(s0, r4.x)), fma_s(s3, r4.w, mul_s(s2, r4.z)));
                    y = red16(y);
                    if (kq == 0) yb[s * 16 + rowl] = y;
                    w4 = nw; k4 = nk; kk4 = nkk; b4 = nb; r4 = nr; vv = nv; }
            } else {
                if (c > 0) scan_yout(ybuf + ((c - 1) & 1) * (SC_CH * 16), mix, mrow0 + (c - 1) * SC_CH, colbase, lt);
                if (c + 1 < SEQ / SC_CH) scan_commit(rsi, rsw, rsv, buf + ((c + 1) & 1) * SC_BUFF, lt);
                if (c + 2 < SEQ / SC_CH) scan_issue(rsi, rsw, rsv, SI, SW, SV, ib, q4, c + 2, lt);
            }
            __syncthreads();
        }
        if (loader) scan_yout(ybuf + ((SEQ / SC_CH - 1) & 1) * (SC_CH * 16), mix, mrow0 + (SEQ / SC_CH - 1) * SC_CH, colbase, lt);
        __syncthreads();
    }
}
constexpr int PCI_BYTES = 10496, PC_WAVE_LDS = 16192;
__device__ __forceinline__ u32x4 pack8v(f32x4 lo, f32x4 hi) { u32x4 w; w.x = pk_bf16(lo.x, lo.y); w.y = pk_bf16(lo.z, lo.w); w.z = pk_bf16(hi.x, hi.y); w.w = pk_bf16(hi.z, hi.w); return w; }
__device__ __forceinline__ float wsum_dpp(float x) { x = red16(x);
    return (__builtin_bit_cast(float, __builtin_amdgcn_readlane(__builtin_bit_cast(int, x), 0)) + __builtin_bit_cast(float, __builtin_amdgcn_readlane(__builtin_bit_cast(int, x), 16)))
         + (__builtin_bit_cast(float, __builtin_amdgcn_readlane(__builtin_bit_cast(int, x), 32)) + __builtin_bit_cast(float, __builtin_amdgcn_readlane(__builtin_bit_cast(int, x), 48))); }
__device__ __forceinline__ void pc_phase(LAS unsigned char* lds, const bf16* Pp_, const bf16* LO, const float* mu, const float* w0, const float* a0, const float* k_k, const float* k_a, const float* r_k,
                                         bf16* SV, float* COEF, unsigned char* OPS, int bid, int G, int wave, int lane) {
    LAS bf16* XKK = (LAS bf16*)(lds + wave * PC_WAVE_LDS); LAS bf16* XR = XKK + 1152; LAS bf16* XK = XR + 1152; LAS bf16* XB = XK + 1152;
    LAS float* AKB = (LAS float*)(XB + 1152); LAS float* AKK = AKB + 320; LAS float* ARK = AKK + 272; LAS float* ARB = ARK + 272; LAS float* TT = ARB + 272; LAS float* M1 = TT + 272; LAS float* PCL = M1 + 272;
#define PC_FENCE() asm volatile("s_waitcnt lgkmcnt(0)" ::: "memory")
    const int m = lane & 15, g = lane >> 4; const f32x4 zero = {0.f, 0.f, 0.f, 0.f};
    for (int item = bid * NWAVES + wave; item < 16384; item += G * NWAVES) {
        const size_t ib = (size_t)item * 16;
        const int bh = item >> 8, c = item & 255, b = bh >> 4, h = bh & 15, ch = h * 64 + lane; const int m0 = b * SEQ + c * 16;
        const float mu_r = mu[ch], mu_k = mu[1024 + ch], mu_v = mu[2048 + ch], w0c = w0[ch], a0c = a0[ch], kkc = k_k[ch], kac = k_a[ch], rkc = r_k[ch];
        unsigned short sr_[17], sk_[17], sv_[17], slw[16], sla[16];
        { const bf16* pp = Pp_ + (size_t)(c > 0 ? m0 - 1 : m0) * EV_IN_P + 3072 + ch; sr_[0] = pp[0]; sk_[0] = pp[1024]; sv_[0] = pp[2048]; }
#pragma unroll
        for (int t = 0; t < 16; ++t) { const bf16* pr = Pp_ + (size_t)(m0 + t) * EV_IN_P + 3072 + ch; sr_[t + 1] = pr[0]; sk_[t + 1] = pr[1024]; sv_[t + 1] = pr[2048];
            const bf16* lo = LO + (size_t)(m0 + t) * LORA_N + ch; slw[t] = lo[0]; sla[t] = lo[1024]; }
        const float z1 = (c > 0) ? 1.0f : 0.0f;
        float P = 1.0f, r1 = bf2f(sr_[0]) * z1, k1 = bf2f(sk_[0]) * z1, v1 = bf2f(sv_[0]) * z1;
#pragma unroll
        for (int t = 0; t < 16; ++t) {
            const float r0 = bf2f(sr_[t + 1]), k0 = bf2f(sk_[t + 1]), v0 = bf2f(sv_[t + 1]);
            const float r = r0 + (r1 - r0) * mu_r, k = k0 + (k1 - k0) * mu_k, v = v0 + (v1 - v0) * mu_v; r1 = r0; k1 = k0; v1 = v0;
            const float z = -(w0c + bf2f(slw[t])); const float sp = fmaxf(z, 0.f) + flog(1.0f + fexp(-fabsf(z))); const float w = -sp - 0.5f;
            const float dec = fexp(-fexp(w)); const float a = fsigmoid(a0c + bf2f(sla[t]));
            float kk = k * kkc; const float n2 = wsum_dpp(kk * kk); kk = kk / fmaxf(sqrtf(n2), 1e-12f);
            const float kp = bf2f(f2bf(k * (1.0f + (a - 1.0f) * kac))), bb = bf2f(f2bf(kk * a)), rr = bf2f(f2bf(r)); kk = bf2f(f2bf(kk));
            const float coef = wsum_dpp(rr * kp * rkc);
            SV[(ib + t) * 64 + lane] = f2bf(v);
            if (lane == 0) COEF[(size_t)(m0 + t) * 16 + h] = coef;
            const float Pp = P; P *= dec; const float inv = 1.0f / P;
            XKK[t * 72 + lane] = f2bf(kk * Pp); XR[t * 72 + lane] = f2bf(rr * P); XK[t * 72 + lane] = f2bf(kp * inv); XB[t * 72 + lane] = f2bf(bb * inv); }
        PCL[lane] = P;
        PC_FENCE();
        { f32x4 akb = zero, akk = zero, ark = zero, arb = zero;
#pragma unroll
          for (int ks = 0; ks < 2; ++ks) { const int o = m * 72 + 32 * ks + 8 * g;
              const bf16x8 fkk = *(const LAS bf16x8*)(XKK + o), fr = *(const LAS bf16x8*)(XR + o), fk = *(const LAS bf16x8*)(XK + o), fb = *(const LAS bf16x8*)(XB + o);
              akb = __builtin_amdgcn_mfma_f32_16x16x32_bf16(fkk, fb, akb, 0, 0, 0); akk = __builtin_amdgcn_mfma_f32_16x16x32_bf16(fkk, fk, akk, 0, 0, 0);
              ark = __builtin_amdgcn_mfma_f32_16x16x32_bf16(fr, fk, ark, 0, 0, 0); arb = __builtin_amdgcn_mfma_f32_16x16x32_bf16(fr, fb, arb, 0, 0, 0); }
#pragma unroll
          for (int r = 0; r < 4; ++r) { const int i = 4 * g + r, j = m;
              AKB[i * 20 + j] = (j < i) ? akb[r] : 0.f; AKK[i * 17 + j] = (j < i) ? akk[r] : 0.f; ARK[i * 17 + j] = (j <= i) ? ark[r] : 0.f; ARB[i * 17 + j] = (j <= i) ? arb[r] : 0.f; } }
        PC_FENCE();
        { const int j = m; float Tc[16]; f32x4 Lc[4], Ln[4];
#pragma unroll
          for (int c4 = 0; c4 < 4; ++c4) Lc[c4] = *(const LAS f32x4*)(AKB + 20 + 4 * c4);
          Tc[0] = (j == 0) ? 1.0f : 0.0f;
#pragma unroll
          for (int i = 1; i < 16; ++i) {
              if (i + 1 < 16) {
#pragma unroll
                  for (int c4 = 0; c4 < 4; ++c4) Ln[c4] = *(const LAS f32x4*)(AKB + (i + 1) * 20 + 4 * c4); }
              float a4[4] = {0.f, 0.f, 0.f, 0.f};
#pragma unroll
              for (int mm = 0; mm < i; ++mm) a4[mm & 3] += Lc[mm >> 2][mm & 3] * Tc[mm];
              Tc[i] = ((i == j) ? 1.0f : 0.0f) - ((a4[0] + a4[1]) + (a4[2] + a4[3]));
#pragma unroll
              for (int c4 = 0; c4 < 4; ++c4) Lc[c4] = Ln[c4]; }
#pragma unroll
          for (int i = 0; i < 16; ++i) TT[i * 17 + j] = Tc[i]; }
        PC_FENCE();
#pragma unroll
        for (int q = 0; q < 4; ++q) { const int i = g + 4 * q, j = m; float acc = 0.f;
#pragma unroll
            for (int mm = 0; mm < 16; ++mm) acc += TT[i * 17 + mm] * AKK[mm * 17 + j];
            M1[i * 17 + j] = acc; }
        PC_FENCE();
        { unsigned char* ob = OPS + (size_t)item * PCI_BYTES;
#pragma unroll
          for (int ks = 0; ks < 2; ++ks) { u32x4 w; const LAS u32x2* p0 = (const LAS u32x2*)(XKK + m * 72 + 32 * ks + 4 * g); const LAS u32x2* p1 = (const LAS u32x2*)(XKK + m * 72 + 32 * ks + 16 + 4 * g);
              u32x2 a = *p0, b = *p1; w.x = a.x; w.y = a.y; w.z = b.x; w.w = b.y; *(u32x4*)(ob + ks * 1024 + lane * 16) = w;
              p0 = (const LAS u32x2*)(XR + m * 72 + 32 * ks + 4 * g); p1 = (const LAS u32x2*)(XR + m * 72 + 32 * ks + 16 + 4 * g);
              a = *p0; b = *p1; w.x = a.x; w.y = a.y; w.z = b.x; w.w = b.y; *(u32x4*)(ob + (2 + ks) * 1024 + lane * 16) = w; }
          { f32x4 lo, hi;
#pragma unroll
            for (int j = 0; j < 4; ++j) { lo[j] = TT[m * 17 + 4 * g + j]; hi[j] = M1[m * 17 + 4 * g + j]; }
            *(u32x4*)(ob + 4 * 1024 + lane * 16) = pack8v(lo, hi);
#pragma unroll
            for (int j = 0; j < 4; ++j) { lo[j] = ARK[m * 17 + 4 * g + j]; hi[j] = -ARB[m * 17 + 4 * g + j]; }
            *(u32x4*)(ob + 5 * 1024 + lane * 16) = pack8v(lo, hi); }
#pragma unroll
          for (int kt = 0; kt < 4; ++kt) { const int kcol = 16 * kt + m; const float pc = PCL[kcol]; f32x4 lo, hi;
#pragma unroll
              for (int j = 0; j < 4; ++j) { lo[j] = bf2f(XK[(4 * g + j) * 72 + kcol]) * pc; hi[j] = -bf2f(XB[(4 * g + j) * 72 + kcol]) * pc; }
              *(u32x4*)(ob + (6 + kt) * 1024 + lane * 16) = pack8v(lo, hi); }
          *(float*)(ob + 10240 + lane * 4) = P; }
        PC_FENCE();
    }
#undef PC_FENCE
}
constexpr int SG = 4, SG_OPS = SG * PCI_BYTES, SG_BYTES = SG_OPS + SG * 2048, SG_N16 = SG_BYTES / 16, SG_NL = (SG_N16 + 255) / 256;
typedef float f32x4m __attribute__((ext_vector_type(4)));
__device__ __forceinline__ void sc2_issue(u32x4 (&R)[SG_NL], const unsigned char* ops, const unsigned char* sv, int grp, int lt) {
    if (grp > 63) grp = 63;
    const unsigned char* og = ops + (size_t)grp * SG_OPS; const unsigned char* vg = sv + (size_t)grp * (SG * 2048);
#pragma unroll
    for (int i = 0; i < SG_NL; ++i) { int idx = lt + 256 * i; idx = idx < SG_N16 ? idx : SG_N16 - 1;
        const unsigned char* p = (idx < SG_OPS / 16) ? (og + (size_t)idx * 16) : (vg + (size_t)(idx - SG_OPS / 16) * 16); R[i] = *(const u32x4*)p; }
}
__device__ __forceinline__ void sc2_commit(const u32x4 (&R)[SG_NL], LAS unsigned char* buf, int lt) {
#pragma unroll
    for (int i = 0; i < SG_NL; ++i) { int idx = lt + 256 * i; idx = idx < SG_N16 ? idx : SG_N16 - 1; *(LAS u32x4*)(buf + idx * 16) = R[i]; }
}
__device__ __forceinline__ void sc2_compute(f32x4 (&Z)[4], const LAS unsigned char* buf, bf16* yout, int lane, int vq) {
    const int m = lane & 15, g = lane >> 4; const f32x4 zero = {0.f, 0.f, 0.f, 0.f};
#pragma unroll 1
    for (int ci = 0; ci < SG; ++ci) { const LAS unsigned char* ob = buf + ci * PCI_BYTES + lane * 16;
        const bf16x8 op1_0 = *(const LAS bf16x8*)ob, op1_1 = *(const LAS bf16x8*)(ob + 1024), op3_0 = *(const LAS bf16x8*)(ob + 2048), op3_1 = *(const LAS bf16x8*)(ob + 3072),
                     op2 = *(const LAS bf16x8*)(ob + 4096), op4 = *(const LAS bf16x8*)(ob + 5120);
        const LAS unsigned short* vp = (const LAS unsigned short*)(buf + SG_OPS + ((ci * 16 + 4 * g) * 64 + vq * 16 + m) * 2);
        const short v0 = (short)vp[0], v1 = (short)vp[64], v2 = (short)vp[128], v3 = (short)vp[192];
        const bf16x8 zb0 = __builtin_bit_cast(bf16x8, pack8v(Z[0], Z[1])), zb1 = __builtin_bit_cast(bf16x8, pack8v(Z[2], Z[3]));
        f32x4 Gm = __builtin_amdgcn_mfma_f32_16x16x32_bf16(op1_0, zb0, zero, 0, 0, 0); Gm = __builtin_amdgcn_mfma_f32_16x16x32_bf16(op1_1, zb1, Gm, 0, 0, 0);
        f32x4 Y = __builtin_amdgcn_mfma_f32_16x16x32_bf16(op3_0, zb0, zero, 0, 0, 0); Y = __builtin_amdgcn_mfma_f32_16x16x32_bf16(op3_1, zb1, Y, 0, 0, 0);
        const unsigned g01 = pk_bf16(Gm.x, Gm.y), g23 = pk_bf16(Gm.z, Gm.w);
        bf16x8 B2; B2[0] = (short)(g01 & 0xffff); B2[1] = (short)(g01 >> 16); B2[2] = (short)(g23 & 0xffff); B2[3] = (short)(g23 >> 16); B2[4] = v0; B2[5] = v1; B2[6] = v2; B2[7] = v3;
        const f32x4 U = __builtin_amdgcn_mfma_f32_16x16x32_bf16(op2, B2, zero, 0, 0, 0);
        const unsigned u01 = pk_bf16(U.x, U.y), u23 = pk_bf16(U.z, U.w);
        bf16x8 B3; B3[0] = v0; B3[1] = v1; B3[2] = v2; B3[3] = v3; B3[4] = (short)(u01 & 0xffff); B3[5] = (short)(u01 >> 16); B3[6] = (short)(u23 & 0xffff); B3[7] = (short)(u23 >> 16);
        Y = __builtin_amdgcn_mfma_f32_16x16x32_bf16(op4, B3, Y, 0, 0, 0);
#pragma unroll
        for (int kt = 0; kt < 4; ++kt) { const bf16x8 op5 = *(const LAS bf16x8*)(ob + (6 + kt) * 1024); const f32x4 pc = *(const LAS f32x4*)(buf + ci * PCI_BYTES + 10240 + (16 * kt + 4 * g) * 4);
            Z[kt] = __builtin_amdgcn_mfma_f32_16x16x32_bf16(op5, B3, Z[kt] * pc, 0, 0, 0); }
        bf16* yp = yout + (size_t)(ci * 16 + 4 * g) * D;
        yp[0] = f2bf(Y.x); yp[D] = f2bf(Y.y); yp[2 * D] = f2bf(Y.z); yp[3 * D] = f2bf(Y.w); }
}
__device__ __forceinline__ void scan2_phase(LAS unsigned char* lds, const unsigned char* OPS, const bf16* SV, bf16* mix, int bid, int G, int tid) {
    const int wid = __builtin_amdgcn_readfirstlane(tid >> 6), lane = tid & 63, lt = tid & 255; const bool loader = wid >= 4;
    LAS unsigned char* buf0 = lds; LAS unsigned char* buf1 = lds + SG_BYTES;
    for (int bh = bid; bh < 64; bh += G) { const int b = bh >> 4, h = bh & 15;
        const unsigned char* ops = OPS + (size_t)bh * 256 * PCI_BYTES; const unsigned char* sv = (const unsigned char*)(SV + (size_t)bh * SEQ * 64);
        bf16* ybase = mix + (size_t)(b * SEQ) * D + 1024 + h * 64 + (wid & 3) * 16 + (lane & 15);
        u32x4 ra[SG_NL], rb[SG_NL]; f32x4 Z[4];
#pragma unroll
        for (int kt = 0; kt < 4; ++kt) Z[kt] = (f32x4){0.f, 0.f, 0.f, 0.f};
        if (loader) { sc2_issue(ra, ops, sv, 0, lt); sc2_issue(rb, ops, sv, 1, lt); sc2_commit(ra, buf0, lt); sc2_issue(ra, ops, sv, 2, lt); }
        __syncthreads();
        for (int gi = 0; gi < 64; gi += 2) {
            if (!loader) sc2_compute(Z, buf0, ybase + (size_t)(gi * SG * 16) * D, lane, wid & 3);
            else { sc2_commit(rb, buf1, lt); sc2_issue(rb, ops, sv, gi + 3, lt); }
            __syncthreads();
            if (!loader) sc2_compute(Z, buf1, ybase + (size_t)((gi + 1) * SG * 16) * D, lane, wid & 3);
            else { sc2_commit(ra, buf0, lt); sc2_issue(ra, ops, sv, gi + 4, lt); }
            __syncthreads();
        }
    }
}
__device__ __forceinline__ void o2_phase(const bf16* P, const float* qnorm, const float* kvnorm, const float* rope, bf16* PD, bf16* QN, bf16* KVN, bf16* KPE, int gw, int ngw, int lane) {
    float qg[8], kg[8];
#pragma unroll
    for (int e = 0; e < 8; ++e) { qg[e] = qnorm[lane * 8 + e]; kg[e] = kvnorm[lane * 8 + e]; }
    const int win = 2 << (lane >> 4);
    for (int m = gw; m < T; m += ngw) { const int t = m & (SEQ - 1); const bf16* pr = P + (size_t)m * OD_IN_P;
        { float u[8], acc[8], tmp[8]; unpack8(*(const u32x4*)(pr + lane * 8), u);
#pragma unroll
          for (int e = 0; e < 8; ++e) acc[e] = u[e];
          const int cnt = (t + 1 < win) ? (t + 1) : win;
          for (int j = 1; j < cnt; ++j) { unpack8(*(const u32x4*)(pr - (size_t)j * OD_IN_P + lane * 8), tmp);
#pragma unroll
              for (int e = 0; e < 8; ++e) acc[e] += tmp[e]; }
          const float ic = 1.0f / (float)cnt;
#pragma unroll
          for (int e = 0; e < 8; ++e) acc[e] = acc[e] * ic - u[e];
          *(u32x4*)(PD + (size_t)m * 512 + lane * 8) = pack8(acc); }
        { float q[8]; unpack8(*(const u32x4*)(pr + 512 + lane * 8), q); float s = 0.f;
#pragma unroll
          for (int e = 0; e < 8; ++e) s += q[e] * q[e];
          s = wave_sum(s); const float sc = rsqrtf(s * (1.0f / 512.0f) + NORM_EPS);
#pragma unroll
          for (int e = 0; e < 8; ++e) q[e] = q[e] * sc * qg[e];
          *(u32x4*)(QN + (size_t)m * 512 + lane * 8) = pack8(q); }
        { float q[8]; unpack8(*(const u32x4*)(pr + 1024 + lane * 8), q); float s = 0.f;
#pragma unroll
          for (int e = 0; e < 8; ++e) s += q[e] * q[e];
          s = wave_sum(s); const float sc = rsqrtf(s * (1.0f / 512.0f) + NORM_EPS);
#pragma unroll
          for (int e = 0; e < 8; ++e) q[e] = q[e] * sc * kg[e];
          *(u32x4*)(KVN + (size_t)m * 512 + lane * 8) = pack8(q); }
        { const int i = lane & 31; const float t1 = bf2f(pr[1536 + i]), t2 = bf2f(pr[1568 + i]); const float cs = rope[(size_t)m * 64 + 2 * i], sn = rope[(size_t)m * 64 + 2 * i + 1];
          const float o = (lane < 32) ? (t1 * cs - t2 * sn) : (t1 * sn + t2 * cs);
          KPE[(size_t)m * 64 + lane] = f2bf(o); }
    }
}
__device__ __forceinline__ s16x4 vtr(const LAS unsigned char* p) { typedef short v4i16_t __attribute__((ext_vector_type(4))); return __builtin_bit_cast(s16x4, __builtin_amdgcn_ds_read_tr16_b64_v4i16((LAS v4i16_t*)p)); }
__device__ __forceinline__ float at_max3(float a, float b, float c) { float r; asm("v_max3_f32 %0, %1, %2, %3" : "=v"(r) : "v"(a), "v"(b), "v"(c)); return r; }
constexpr int AT_KROW = 400, AT_VROW = 320, AT_KB = 64 * AT_KROW, AT_VB = 64 * AT_VROW, AT_BUF = AT_KB + AT_VB;
constexpr int AT_UNITS = 4 * 12 * 16;
__device__ __forceinline__ void attn_phase(LAS unsigned char* lds, const bf16* Q, const bf16* KV, const bf16* KPE, const float* rope, bf16* mix, int bid, int G, int tid) {
    const int wid = __builtin_amdgcn_readfirstlane(tid >> 6);
    const float qs = 0.07216878364870322f * 1.4426950408889634f;
    for (int round = 0; round * G < AT_UNITS; ++round) {
        int idx;
        if (G == 256) { const int i2 = bid >> 1, od = bid & 1;
            idx = (round == 0) ? bid : (round == 1 ? 256 + (od ? 127 - i2 : 255 - i2) : 512 + (od ? 255 - i2 : 127 - i2)); }
        else idx = (round & 1) ? (round * G + (G - 1 - bid)) : (round * G + bid);
        if (idx >= AT_UNITS) continue;
        int tid_r = tid; asm volatile("" : "+v"(tid_r));
        const int lane = tid_r & 63, l32 = lane & 31, hh = lane >> 5;
        const int sr16 = tid_r >> 4, sc16 = tid_r & 15, sr8 = tid_r >> 3, sc8 = tid_r & 7;
        const int qb = 15 - idx / 48, bh = idx % 48, b = bh / 12, h = bh - b * 12;
        const int q0 = qb * 256, mrow0 = b * SEQ, ntiles = (qb + 1) * 4;
        const int qrow = mrow0 + q0 + wid * 32 + l32;
        bf16x8 qf[12];
        { const bf16* qp = Q + (size_t)qrow * 2304 + h * 192 + hh * 8; const float* rp = rope + (size_t)qrow * 64;
#pragma unroll
          for (int ks = 0; ks < 8; ++ks) { float f[8]; unpack8(*(const u32x4*)(qp + ks * 16), f);
#pragma unroll
              for (int e = 0; e < 8; ++e) f[e] *= qs;
              qf[ks] = __builtin_bit_cast(bf16x8, pack8(f)); if (ks & 1) asm volatile("" ::: "memory"); }
#pragma unroll
          for (int ks = 8; ks < 10; ++ks) { float f1[8], f2[8], o1[8], o2[8]; unpack8(*(const u32x4*)(qp + ks * 16), f1); unpack8(*(const u32x4*)(qp + (ks + 2) * 16), f2);
#pragma unroll
              for (int e = 0; e < 8; ++e) { const int i = (ks - 8) * 16 + hh * 8 + e; const float cs = rp[2 * i], sn = rp[2 * i + 1];
                  o1[e] = (f1[e] * cs - f2[e] * sn) * qs; o2[e] = (f1[e] * sn + f2[e] * cs) * qs; }
              qf[ks] = __builtin_bit_cast(bf16x8, pack8(o1)); qf[ks + 2] = __builtin_bit_cast(bf16x8, pack8(o2)); asm volatile("" ::: "memory"); } }
        f32x16 O[4];
#pragma unroll
        for (int i = 0; i < 4; ++i)
#pragma unroll
            for (int e = 0; e < 16; ++e) O[i][e] = 0.f;
        float mrun = -1e30f, lrun = 0.f;
        u32x4 sk[3], sv[2];
        const char* kvb = (const char*)(KV + (size_t)mrow0 * 3072 + h * 256); const char* kpb = (const char*)(KPE + (size_t)mrow0 * 64);
        const unsigned kvo = (unsigned)(sr16 * 3072 + sc16 * 8) * 2u, kpo = (unsigned)(sr8 * 64 + sc8 * 8) * 2u;
#define AT_ISSUE(kt) do { const char* p_ = kvb + (size_t)(kt) * (64 * 3072 * 2); const char* q_ = kpb + (size_t)(kt) * (64 * 64 * 2); \
        sk[0] = *(const u32x4*)(p_ + kvo); sk[1] = *(const u32x4*)(p_ + (kvo + 32u * 3072u * 2u)); sv[0] = *(const u32x4*)(p_ + (kvo + 256u)); sv[1] = *(const u32x4*)(p_ + (kvo + 32u * 3072u * 2u + 256u)); \
        sk[2] = *(const u32x4*)(q_ + kpo); } while (0)
#define AT_COMMIT(bufp) do { LAS unsigned char* b_ = (bufp); \
        *(LAS u32x4*)(b_ + sr16 * AT_KROW + sc16 * 16) = sk[0]; *(LAS u32x4*)(b_ + (sr16 + 32) * AT_KROW + sc16 * 16) = sk[1]; \
        *(LAS u32x4*)(b_ + sr8 * AT_KROW + 256 + sc8 * 16) = sk[2]; \
        *(LAS u32x4*)(b_ + AT_KB + sr16 * AT_VROW + sc16 * 16) = sv[0]; *(LAS u32x4*)(b_ + AT_KB + (sr16 + 32) * AT_VROW + sc16 * 16) = sv[1]; } while (0)
        AT_ISSUE(0); AT_COMMIT(lds);
        __syncthreads();
        const int qlo = q0 + wid * 32;
        for (int kt = 0; kt < ntiles; ++kt) {
            if (kt + 1 < ntiles) AT_ISSUE(kt + 1);
            const int key0 = kt * 64;
            const LAS unsigned char* kb_ = lds + (kt & 1) * AT_BUF; const LAS unsigned char* vb_ = kb_ + AT_KB;
            if (key0 <= qlo + 31) {
                f32x16 S0, S1;
#pragma unroll
                for (int e = 0; e < 16; ++e) { S0[e] = 0.f; S1[e] = 0.f; }
                const LAS unsigned char* ka = kb_ + l32 * AT_KROW + hh * 16;
                bf16x8 kf[2][4];
#define AT_LDK(buf, grp) do { _Pragma("unroll") for (int q_ = 0; q_ < 2; ++q_) { kf[buf][2 * q_] = *(const LAS bf16x8*)(ka + ((grp) * 2 + q_) * 32); kf[buf][2 * q_ + 1] = *(const LAS bf16x8*)(ka + 32 * AT_KROW + ((grp) * 2 + q_) * 32); } } while (0)
                AT_LDK(0, 0); __builtin_amdgcn_sched_barrier(0);
#pragma unroll
                for (int grp = 0; grp < 6; ++grp) {
                    if (grp < 5) { AT_LDK((grp + 1) & 1, grp + 1); }
                    __builtin_amdgcn_sched_barrier(0);
                    __builtin_amdgcn_s_setprio(1);
#pragma unroll
                    for (int q_ = 0; q_ < 2; ++q_) {
                        S0 = __builtin_amdgcn_mfma_f32_32x32x16_bf16(kf[grp & 1][2 * q_], qf[grp * 2 + q_], S0, 0, 0, 0);
                        S1 = __builtin_amdgcn_mfma_f32_32x32x16_bf16(kf[grp & 1][2 * q_ + 1], qf[grp * 2 + q_], S1, 0, 0, 0); }
                    __builtin_amdgcn_s_setprio(0);
                    __builtin_amdgcn_sched_barrier(0); }
#undef AT_LDK
                const LAS unsigned char* va = vb_ + (4 * hh + ((lane & 15) >> 2)) * AT_VROW + (16 * ((lane >> 4) & 1) + 4 * (lane & 3)) * 2;
                s16x4 vf[2][4];
#define AT_LDV(buf, hs) do { const LAS unsigned char* vp_ = va + ((((hs) >> 1) >> 1) * 32 + 16 * (((hs) >> 1) & 1)) * AT_VROW + ((hs) & 1) * 128; _Pragma("unroll") for (int d_ = 0; d_ < 2; ++d_) { vf[buf][2 * d_] = vtr(vp_ + d_ * 64); vf[buf][2 * d_ + 1] = vtr(vp_ + 8 * AT_VROW + d_ * 64); } } while (0)
                AT_LDV(0, 0); __builtin_amdgcn_sched_barrier(0);
                if (key0 + 63 > qlo) { const int qq = qlo + l32;
#pragma unroll
                    for (int e = 0; e < 16; ++e) { const int key = key0 + 8 * (e >> 2) + 4 * hh + (e & 3);
                        if (key > qq) S0[e] = -1e30f; if (key + 32 > qq) S1[e] = -1e30f; } }
                float mxa = at_max3(S0[0], S0[1], S1[0]), mxb = at_max3(S0[2], S0[3], S1[1]); mxa = at_max3(mxa, S1[2], S1[3]);
#pragma unroll
                for (int e = 4; e < 16; e += 4) { mxa = at_max3(mxa, S0[e], S0[e + 1]); mxb = at_max3(mxb, S0[e + 2], S0[e + 3]); mxa = at_max3(mxa, S1[e], S1[e + 1]); mxb = at_max3(mxb, S1[e + 2], S1[e + 3]); }
                float mx = fmaxf(mxa, mxb);
                mx = fmaxf(mx, __shfl_xor(mx, 32));
                const float mnew = (mx > mrun + 6.0f) ? mx : mrun;
                const float alpha = __builtin_amdgcn_exp2f(mrun - mnew); mrun = mnew;
                float rs = 0.f;
#pragma unroll
                for (int e = 0; e < 16; ++e) { S0[e] = __builtin_amdgcn_exp2f(S0[e] - mnew); S1[e] = __builtin_amdgcn_exp2f(S1[e] - mnew); rs += S0[e] + S1[e]; }
                lrun = lrun * alpha + rs;
                if (__builtin_amdgcn_ballot_w64(alpha != 1.0f) != 0ull) {
#pragma unroll
                    for (int i = 0; i < 4; ++i)
#pragma unroll
                        for (int e = 0; e < 16; ++e) O[i][e] *= alpha; }
#pragma unroll
                for (int hs = 0; hs < 8; ++hs) { const int st = hs >> 1;
                    if (hs < 7) { AT_LDV((hs + 1) & 1, hs + 1); }
                    __builtin_amdgcn_sched_barrier(0);
                    float pf[8];
#pragma unroll
                    for (int e = 0; e < 8; ++e) pf[e] = (st >> 1) ? S1[8 * (st & 1) + e] : S0[8 * (st & 1) + e];
                    const bf16x8 pb = __builtin_bit_cast(bf16x8, pack8(pf));
#pragma unroll
                    for (int d_ = 0; d_ < 2; ++d_) { const int dvt = (hs & 1) * 2 + d_; const s16x4 lo = vf[hs & 1][2 * d_], hi = vf[hs & 1][2 * d_ + 1];
                        const bf16x8 A = (bf16x8){lo[0], lo[1], lo[2], lo[3], hi[0], hi[1], hi[2], hi[3]};
                        __builtin_amdgcn_s_setprio(1); O[dvt] = __builtin_amdgcn_mfma_f32_32x32x16_bf16(A, pb, O[dvt], 0, 0, 0); __builtin_amdgcn_s_setprio(0); }
                    __builtin_amdgcn_sched_barrier(0); }
#undef AT_LDV
            }
            if (kt + 1 < ntiles) AT_COMMIT(lds + ((kt + 1) & 1) * AT_BUF);
            __syncthreads();
        }
#undef AT_ISSUE
#undef AT_COMMIT
        const float ltot = lrun + __shfl_xor(lrun, 32); const float inv = 1.0f / ltot;
        bf16* op = mix + (size_t)qrow * D + 512 + h * 128 + 4 * hh;
#pragma unroll
        for (int dvt = 0; dvt < 4; ++dvt)
#pragma unroll
            for (int g4 = 0; g4 < 4; ++g4) { u32x2 w; w.x = pk_bf16(O[dvt][4 * g4] * inv, O[dvt][4 * g4 + 1] * inv); w.y = pk_bf16(O[dvt][4 * g4 + 2] * inv, O[dvt][4 * g4 + 3] * inv);
                *(u32x2*)(op + dvt * 32 + 8 * g4) = w; }
    }
}
#define XB_TMO      128
#define XB_XCNT(j)  (256  + 64 * (j))
#define XB_XSUB(j)  (1280 + 64 * (j))
#define XB_XGEN(j)  (2304 + 64 * (j))
#define XB_TOP      3328
#define XB_TOPGEN   3392
#define XCD_BAR_WORDS 3456
#define XB_SPIN_CAP (1u << 18)

__device__ __forceinline__ unsigned xb_ld(unsigned* p)              { return __hip_atomic_load(p, __ATOMIC_RELAXED, __HIP_MEMORY_SCOPE_AGENT); }
__device__ __forceinline__ unsigned xb_add(unsigned* p, unsigned v) { return __hip_atomic_fetch_add(p, v, __ATOMIC_RELAXED, __HIP_MEMORY_SCOPE_AGENT); }
__device__ __forceinline__ unsigned xb_xcc_id() { return (unsigned)__builtin_amdgcn_s_getreg((3 << 11) | 20) & 0xFu; }
#define XB_SPIN(cond, bar) do { unsigned _sp = 0; while (cond) { __builtin_amdgcn_s_sleep(1); \
    if ((++_sp & 255u) == 0u) { if (xb_ld(&(bar)[XB_TMO])) break; if (_sp > XB_SPIN_CAP) { atomicAdd(&(bar)[XB_TMO], 1u); break; } } } } while (0)

struct XcdBarrier {
    unsigned* bar; unsigned x;
    volatile __attribute__((address_space(3))) unsigned* st;
};

__device__ __forceinline__ XcdBarrier xcd_barrier_post(unsigned* bar, volatile __attribute__((address_space(3))) unsigned* st) {
    XcdBarrier b; b.bar = bar; b.x = xb_xcc_id(); b.st = st;
    if (threadIdx.x == 0) (void)xb_add(&bar[XB_XCNT(b.x)], 1u);
    return b;
}
__device__ __forceinline__ void xcd_barrier_complete(unsigned* bar, unsigned x, unsigned& nloc, unsigned& nx) {
    const unsigned G = gridDim.x * gridDim.y * gridDim.z;
    unsigned sum, cnt, mine, sp = 0u;
    for (;;) {
        sum = 0u; cnt = 0u; mine = 0u;
#pragma unroll
        for (unsigned j = 0; j < 16; ++j) { const unsigned c = xb_ld(&bar[XB_XCNT(j)]); sum += c; cnt += (c > 0u) ? 1u : 0u; mine = (j == x) ? c : mine; }
        if (sum == G) break;
        __builtin_amdgcn_s_sleep(1);
        if ((++sp & 255u) == 0u) { if (xb_ld(&bar[XB_TMO])) break; if (sp > XB_SPIN_CAP) { atomicAdd(&bar[XB_TMO], 1u); break; } }
    }
    nloc = mine > 0u ? mine : 1u; nx = cnt > 0u ? cnt : 1u;
}

__device__ __forceinline__ void xcd_barrier(const XcdBarrier& b) {
    asm volatile("s_waitcnt vmcnt(0)" ::: "memory");
    __syncthreads();
    if (threadIdx.x == 0) {
        unsigned* bar = b.bar;
        __builtin_amdgcn_s_waitcnt(0);
        unsigned nloc = b.st[0], nx = b.st[1];
        if (nloc == 0u) { xcd_barrier_complete(bar, b.x, nloc, nx); b.st[0] = nloc; b.st[1] = nx; }
        const unsigned old = xb_add(&bar[XB_XSUB(b.x)], 1u);
        const unsigned gen = old / nloc;
        if (old + 1u == (gen + 1u) * nloc) {
            __builtin_amdgcn_fence(__ATOMIC_RELEASE, "agent");
            asm volatile("s_waitcnt vmcnt(0)" ::: "memory");
            const unsigned og = xb_add(&bar[XB_TOP], 1u);
            const unsigned tg = og / nx;
            if (og + 1u == (tg + 1u) * nx) xb_add(&bar[XB_TOPGEN], 1u);
            else XB_SPIN(xb_ld(&bar[XB_TOPGEN]) == tg, bar);
            __builtin_amdgcn_fence(__ATOMIC_ACQUIRE, "agent");
            xb_add(&bar[XB_XGEN(b.x)], 1u);
            asm volatile("s_waitcnt vmcnt(0)" ::: "memory");
        } else {
            XB_SPIN(xb_ld(&bar[XB_XGEN(b.x)]) == gen, bar);
            __builtin_amdgcn_fence(__ATOMIC_ACQUIRE, "agent");
            asm volatile("s_waitcnt vmcnt(0)" ::: "memory");
        }
    }
    __syncthreads();
}

__device__ __forceinline__ const float* uniform_ptr(const float* p) { const unsigned long long v = (unsigned long long)p;
    const unsigned lo = __builtin_amdgcn_readfirstlane((unsigned)v), hi = __builtin_amdgcn_readfirstlane((unsigned)(v >> 32)); return (const float*)(((unsigned long long)hi << 32) | lo); }
struct Args { const void* in[31]; float* out; unsigned char* ws; int ph_lo, ph_hi; };
constexpr int NPH = 34;

__global__ void __launch_bounds__(NTHREADS, 2) trunk_fwd(Args a) {
    extern __shared__ __attribute__((aligned(16))) unsigned char lds_raw[];
    LAS unsigned char* lds = (LAS unsigned char*)lds_raw;
    cg::grid_group grid = cg::this_grid();
    volatile LAS unsigned* misc = (volatile LAS unsigned*)(lds + 131072 + 1024);
    if (threadIdx.x < 16) misc[threadIdx.x] = 0u;
    __syncthreads();
    XcdBarrier xbar = xcd_barrier_post((unsigned*)(a.ws + WS_CTL), misc + 8);
    { volatile LAS unsigned long long* tab = (volatile LAS unsigned long long*)(lds + 131072 + 2048);
    if (threadIdx.x == 0) {
#define TB(i) tab[i] = (unsigned long long)a.in[i];
        TB(0) TB(1) TB(2) TB(3) TB(4) TB(5) TB(6) TB(7) TB(8) TB(9) TB(10) TB(11) TB(12) TB(13) TB(14) TB(15) TB(16) TB(17) TB(18) TB(19) TB(20)
        TB(21) TB(22) TB(23) TB(24) TB(25) TB(26) TB(27) TB(28) TB(29) TB(30)
#undef TB
    }
    }
    __syncthreads();
#define INF(i) uniform_ptr((const float*)tab[i])
#ifndef REPSEL
#define REPSEL 0
#endif
    for (int vph = a.ph_lo * 2; vph < a.ph_hi * 2; ++vph) {
        const int ph = vph >> 1;
        int kind, L = 0;
        if (ph < 1) kind = 100;
        else { int r = ph - 1; if (r >= 32) { kind = 30; L = 3; } else { if (r >= 16) { r -= 16; L = 2; } if (r >= 9) { r -= 9; L += 1; }
               kind = (L & 1) ? (r < 5 ? 20 + r : 21 + r) : (r < 3 ? r : (r == 3 ? 11 : (r < 7 ? r : r + 1))); } }
        if (vph & 1) {
            bool sel = false;
            if (REPSEL == 1 && (kind == 0 || kind == 2 || kind == 20 || kind == 22 || kind == 8 || kind == 26)) sel = true;
            if (REPSEL == 2 && kind == 23) sel = true;
            if (REPSEL == 3 && kind == 4) sel = true;
            if (REPSEL == 4 && (kind == 1 || kind == 3 || kind == 21 || kind == 7 || kind == 25 || ((kind == 10 || kind == 28) && L + 1 < DEPTH))) sel = true;
            if (REPSEL == 9 && kind == 11) sel = true;
            if (REPSEL == 10 && (kind == 7 || kind == 25 || ((kind == 10 || kind == 28) && L + 1 < DEPTH))) sel = true;
            if (REPSEL == 11 && kind == 3) sel = true;
            if (REPSEL == 6 && kind == 101) sel = true;
            if (REPSEL == 7 && (kind == 1 || kind == 21)) sel = true;
            if (REPSEL == 8 && (kind == 3 || kind == 5)) sel = true;
            if (REPSEL == 5) xcd_barrier(xbar);
            if (!sel) continue;
        }
        if (vph > a.ph_lo * 2) { if (a.ph_hi < 0) grid.sync(); xcd_barrier(xbar); }
        int tid = threadIdx.x; asm volatile("" : "+v"(tid));
        unsigned tb_ = 131072 + 2048; asm volatile("" : "+s"(tb_));
        volatile LAS unsigned long long* tab = (volatile LAS unsigned long long*)(lds + tb_);
        unsigned char* ws = a.ws; asm volatile("" : "+s"(ws));
        float* OUT = a.out; asm volatile("" : "+s"(OUT));
        const int lane = tid & 63, wave = __builtin_amdgcn_readfirstlane(tid >> 6);
        const int bid = blockIdx.x, G = gridDim.x, gw = bid * NWAVES + wave, ngw = G * NWAVES, gtid = bid * NTHREADS + tid, gthreads = G * NTHREADS;
        bf16* H = (bf16*)(ws + WS_XN); bf16* MIX = (bf16*)OUT; float* SSA = (float*)(ws + WS_SS); float* SSB = SSA + (size_t)T * 32;
        bf16* P = (bf16*)(ws + WS_P); bf16* ACT = P;
        bf16* LO = (bf16*)(ws + WS_LO); bf16* QB = LO;
        bf16* AL = (bf16*)(ws + WS_AL); bf16* KPE = AL;
        bf16* SI = (bf16*)(ws + WS_SI); bf16* KVB = SI;
        float* SW = (float*)(ws + WS_SW); bf16* PD = (bf16*)(ws + WS_SW); bf16* QN = PD + (size_t)T * 512; bf16* KVN = QN + (size_t)T * 512;
        bf16* SV = (bf16*)(ws + WS_SV);
        float* ROPE = (float*)(ws + WS_ROPE);
        bf16* FGU = (bf16*)(ws + WS_FGU + (size_t)(L & 1) * SZ_FFN); bf16* FD = (bf16*)(ws + WS_FD + (size_t)(L & 1) * SZ_FFN);
        LAS float* scr = (LAS float*)(lds + wave * 8448);
        const int j = L >> 1;
        int gsel = -1;
        if (kind == 0 || kind == 2 || kind == 20 || kind == 22) gsel = 0;
        else if (kind == 6 || kind == 9 || kind == 24 || kind == 27) gsel = 1;
        else if (kind == 8 || kind == 26) gsel = 2;
        if (kind == 100) {
            for (int jj = 0; jj < 2; ++jj) {
                zero_lora_pool((bf16*)(ws + WS_EVLORA + jj * SZ_EVLORA), (bf16*)(ws + WS_POOL + jj * SZ_POOL), gtid, gthreads);
                zero_fill(ws + WS_EVIN + jj * SZ_EVIN + (size_t)EV_IN * D * 2, (size_t)(EV_IN_P - EV_IN) * D * 2, gtid, gthreads);
                zero_fill(ws + WS_ODIN + jj * SZ_ODIN + (size_t)OD_IN * D * 2, (size_t)(OD_IN_P - OD_IN) * D * 2, gtid, gthreads);
            }
            rope_table((const int*)INF(1), ROPE, gtid, gthreads);
            init_rows(INF(0), H, SSB, gw, ngw, lane);
            for (int jj = 0; jj < 2; ++jj) {
                tr_matrix(INF(3) + (size_t)jj * D * EV_IN, D, EV_IN, (bf16*)(ws + WS_EVIN + jj * SZ_EVIN), D, 0, 0, 0, scr, gw, ngw, lane, nullptr, INF(2) + (size_t)jj * D);
                bf16* lt_ = (bf16*)(ws + WS_EVLORA + jj * SZ_EVLORA);
                tr_matrix(INF(7) + (size_t)jj * 64 * 1024, 64, 1024, lt_, LORA_K, 0, 0, 0, scr, gw, ngw, lane);
                tr_matrix(INF(9) + (size_t)jj * 64 * 1024, 64, 1024, lt_, LORA_K, 64, 0, 1024, scr, gw, ngw, lane);
                tr_matrix(INF(10) + (size_t)jj * 160 * 1024, 160, 1024, lt_, LORA_K, 128, 0, 2048, scr, gw, ngw, lane);
                tr_matrix(INF(16) + (size_t)jj * D * D, D, D, (bf16*)(ws + WS_EVOUT + jj * SZ_WOUT), D, 0, 0, 0, scr, gw, ngw, lane);
                tr_matrix(INF(18) + (size_t)jj * D * OD_IN, D, OD_IN, (bf16*)(ws + WS_ODIN + jj * SZ_ODIN), D, 0, 0, 0, scr, gw, ngw, lane, nullptr, INF(17) + (size_t)jj * D);
                for (int g = 0; g < 4; ++g)
                    tr_matrix(INF(19) + ((size_t)jj * 4 + g) * 128 * 128, 128, 128, (bf16*)(ws + WS_POOL + jj * SZ_POOL), 512, g * 128, 0, g * 128, scr, gw, ngw, lane, INF(20) + (size_t)jj * 512 + g * 128);
                tr_matrix(INF(22) + (size_t)jj * 512 * 2304, 512, 2304, (bf16*)(ws + WS_UQ + jj * SZ_UQ), 512, 0, 0, 0, scr, gw, ngw, lane);
                tr_matrix(INF(24) + (size_t)jj * 512 * 3072, 512, 3072, (bf16*)(ws + WS_UKV + jj * SZ_UKV), 512, 0, 0, 0, scr, gw, ngw, lane);
                tr_matrix(INF(25) + (size_t)jj * D * D, D, D, (bf16*)(ws + WS_ODOUT + jj * SZ_WOUT), D, 0, 0, 0, scr, gw, ngw, lane);
            }
        }
        if (kind == 30) final_rows(H, SSB, INF(30), OUT, gw, ngw, lane);
        if (gsel == 0) {
            const bool part = (kind == 22 && G == 256);
            const int ng = (kind == 22 && !part) ? 3 : 1;
            for (int gq = 0; gq < ng; ++gq) {
                int gi = gq, Gs = G, cs = bid;
                if (part) { if (bid < 24) { gi = 0; Gs = 24; } else if (bid < 120) { gi = 1; Gs = 96; cs = bid - 24; } else { gi = 2; Gs = 136; cs = bid - 120; } }
                pg8::Gemm g; pg8::EpiStore E;
                if (kind == 0) { g = pg8::Gemm{H, (const bf16*)(ws + WS_EVIN + j * SZ_EVIN), T, EV_IN_P, D}; E = pg8::EpiStore{P, EV_IN_P, SSB}; }
                else if (kind == 2) { g = pg8::Gemm{AL, (const bf16*)(ws + WS_EVLORA + j * SZ_EVLORA), T, LORA_N, LORA_K}; E = pg8::EpiStore{LO, LORA_N, nullptr}; }
                else if (kind == 20) { g = pg8::Gemm{H, (const bf16*)(ws + WS_ODIN + j * SZ_ODIN), T, OD_IN_P, D}; E = pg8::EpiStore{P, OD_IN_P, SSB}; }
                else if (gi == 0) { g = pg8::Gemm{PD, (const bf16*)(ws + WS_POOL + j * SZ_POOL), T, 512, 512}; E = pg8::EpiStore{MIX, D, nullptr}; }
                else if (gi == 1) { g = pg8::Gemm{QN, (const bf16*)(ws + WS_UQ + j * SZ_UQ), T, 2304, 512}; E = pg8::EpiStore{QB, 2304, nullptr}; }
                else { g = pg8::Gemm{KVN, (const bf16*)(ws + WS_UKV + j * SZ_UKV), T, 3072, 512}; E = pg8::EpiStore{KVB, 3072, nullptr}; }
                pg8::StaticOrder S; S.init(g.M, g.N, Gs, cs);
                pg8::gemm_phase<pg8::EpiStore, pg8::StaticOrder, true, true>(lds, g, S, E);
            }
        } else if (gsel == 1) {
            pg8::Gemm g;
            if (kind == 6) g = pg8::Gemm{MIX, (const bf16*)(ws + WS_EVOUT + j * SZ_WOUT), T, D, D};
            else if (kind == 24) g = pg8::Gemm{MIX, (const bf16*)(ws + WS_ODOUT + j * SZ_WOUT), T, D, D};
            else g = pg8::Gemm{ACT, FD, T, D, DFF};
            pg8::EpiResid E{H, D, (kind == 6 || kind == 24) ? SSA : SSB};
            pg8::StaticOrder S; S.init(g.M, g.N, G, bid);
            pg8::gemm_phase<pg8::EpiResid, pg8::StaticOrder, true, true>(lds, g, S, E);
        } else if (gsel == 2) {
            pg8::Gemm g{H, FGU, T, 2 * DFF, D}; pg8::EpiSwiglu E{ACT, DFF, SSA};
            pg8::StaticOrder S; S.init(g.M, g.N, G, bid);
            pg8::gemm_phase<pg8::EpiSwiglu, pg8::StaticOrder, true, true>(lds, g, S, E);
        } else if (kind == 1) {
            e2_phase(P, INF(4) + (size_t)j * 1024 * 3, INF(5) + (size_t)j * RWKV_IN, MIX, AL, gw, ngw, lane);
        } else if (kind == 3) {
            e4_phase(P, LO, INF(5) + (size_t)j * RWKV_IN, INF(6) + (size_t)j * 1024, INF(8) + (size_t)j * 1024, INF(11) + (size_t)j * 1024, INF(12) + (size_t)j * 1024, SI, SW, SV, gw, ngw, lane);
        } else if (kind == 4) {
            if (bid < 64) scan2_phase(lds, (const unsigned char*)SI, SV, MIX, bid, G, tid);
            else {
                const int cw = (bid - 64) * NWAVES + wave, ncw = (G - 64) * NWAVES;
                for (int q = 0; q < 2; ++q) { const int LL = L + q; bf16* fgu = (bf16*)(ws + WS_FGU + (size_t)(LL & 1) * SZ_FFN); bf16* fd = (bf16*)(ws + WS_FD + (size_t)(LL & 1) * SZ_FFN);
                    tr_matrix(INF(27) + (size_t)LL * D * DFF, D, DFF, fgu, D, 0, 1, 0, scr, cw, ncw, lane, nullptr, INF(26) + (size_t)LL * D);
                    tr_matrix(INF(28) + (size_t)LL * D * DFF, D, DFF, fgu, D, 0, 1, 128, scr, cw, ncw, lane, nullptr, INF(26) + (size_t)LL * D);
                    tr_matrix(INF(29) + (size_t)LL * DFF * D, DFF, D, fd, DFF, 0, 0, 0, scr, cw, ncw, lane); }
            }
        } else if (kind == 11) {
            pc_phase(lds, P, LO, INF(5) + (size_t)j * RWKV_IN, INF(6) + (size_t)j * 1024, INF(8) + (size_t)j * 1024, INF(11) + (size_t)j * 1024, INF(12) + (size_t)j * 1024, INF(13) + (size_t)j * 1024,
                     SV, SW + (40u << 20) / 4, (unsigned char*)SI, bid, G, wave, lane);
        } else if (kind == 5) {
            e6_phase(LO, SW + (40u << 20) / 4, SV, INF(14) + (size_t)j * 1024, INF(15) + (size_t)j * 1024, MIX, gw, ngw, lane);
        } else if (kind == 21) {
            o2_phase(P, INF(21) + (size_t)j * 512, INF(23) + (size_t)j * 512, ROPE, PD, QN, KVN, KPE, gw, ngw, lane);
        } else if (kind == 23) {
            attn_phase(lds, QB, KVB, KPE, ROPE, MIX, bid, G, tid);
        }
    }
#undef INF
}

extern "C" void kernel_launch(void* const* d_in, const int* in_sizes, int n_in, void* d_out, int out_size, void* d_ws, size_t ws_size, hipStream_t stream) {
    static int grid = 0;
    if (grid == 0) {
        if (n_in != 31 || out_size != T * D || ws_size < WS_END) { fprintf(stderr, "kernel_launch: unexpected problem (n_in %d out %d ws %zu need %zu)\n", n_in, out_size, ws_size, (size_t)WS_END); grid = -1; return; }
        int dev = 0, cus = 0, per_cu = 0;
        hipGetDevice(&dev); hipDeviceGetAttribute(&cus, hipDeviceAttributeMultiprocessorCount, dev);
        if (hipFuncSetAttribute((const void*)trunk_fwd, hipFuncAttributeMaxDynamicSharedMemorySize, LDS_BYTES) != hipSuccess) { fprintf(stderr, "hipFuncSetAttribute failed\n"); grid = -1; return; }
        if (hipOccupancyMaxActiveBlocksPerMultiprocessor(&per_cu, (const void*)trunk_fwd, NTHREADS, LDS_BYTES) != hipSuccess || per_cu < 1) { fprintf(stderr, "occupancy query failed (%d)\n", per_cu); per_cu = 1; }
        (void)hipGetLastError();
        grid = cus * 1;
        fprintf(stderr, "kernel_launch: cus %d per_cu %d grid %d ws %zu need %zu\n", cus, per_cu, grid, ws_size, (size_t)WS_END);
    }
    if (grid < 0) return;
    if (hipMemsetAsync((char*)d_ws + WS_CTL, 0, CTL_BYTES, stream) != hipSuccess) { fprintf(stderr, "memset failed\n"); return; }
    Args a{};
    for (int i = 0; i < 31; ++i) a.in[i] = d_in[i];
    a.out = (float*)d_out; a.ws = (unsigned char*)d_ws;
#ifdef MK_SPLIT
    for (int ph = 0; ph < NPH; ++ph) { a.ph_lo = ph; a.ph_hi = ph + 1; hipLaunchKernelGGL(trunk_fwd, dim3(grid), dim3(NTHREADS), LDS_BYTES, stream, a); }
#else
    a.ph_lo = 0; a.ph_hi = NPH;
    void* args[] = {&a};
    hipError_t e = hipLaunchCooperativeKernel((const void*)trunk_fwd, dim3(grid), dim3(NTHREADS), args, LDS_BYTES, stream);
    if (e != hipSuccess) fprintf(stderr, "cooperative launch failed: %s (grid %d)\n", hipGetErrorString(e), grid);
#endif
}
```
